# Optimizing an MI355X kernel written in HIP

```python
import math
import jax, jax.numpy as jnp
from jax import lax
import numpy as np

D_MODEL = 1024
BATCH = 32
SEQ = 2048
DEPTH = 1

N_HEADS = 8
N_KV_HEADS = 2
HEAD_DIM = 64
KV_REP = N_HEADS // N_KV_HEADS
Q_BLOCK = 128
ROPE_THETA = 10000.0
GRID_W = 64
ROT_HALF = HEAD_DIM // 2
SSM_WIDTH = 256
SSM_GROUP = 16
SSM_GROUPS = SSM_WIDTH // SSM_GROUP
SSM_STATE = 64
N_DIR = 2
N_EXPERTS = 64
EXPERT_DIM = 128
TOP_K = 8
N_EXPERT_GROUPS = 8
TOPK_GROUPS = 4
EXPERTS_PER_GROUP = N_EXPERTS // N_EXPERT_GROUPS
SHARED_DIM = 256
ROUTED_SCALE = 2.5
PLE_DIM = 256
EPS = 1e-6

Q_W = N_HEADS * HEAD_DIM
KV_W = N_KV_HEADS * HEAD_DIM
IN_WIDTH = Q_W + 2 * KV_W + SSM_WIDTH + 2 * D_MODEL
IN_SPLITS = (Q_W, Q_W + KV_W, Q_W + 2 * KV_W, Q_W + 2 * KV_W + SSM_WIDTH,
             Q_W + 2 * KV_W + SSM_WIDTH + D_MODEL)

kernel_name = "hybrid_gqa_s5_moe_encoder"


def rmsnorm(x, g):
    xf = x.astype(jnp.float32)
    y = xf * lax.rsqrt(jnp.mean(xf * xf, axis=-1, keepdims=True) + EPS)
    return (y * g.astype(jnp.float32)).astype(x.dtype)


def _rope_half(x, ang):
    cos = jnp.cos(ang)[None, :, None, :]
    sin = jnp.sin(ang)[None, :, None, :]
    x1, x2 = jnp.split(x, 2, axis=-1)
    return jnp.concatenate([x1 * cos - x2 * sin, x2 * cos + x1 * sin], axis=-1)


def axial_rope(x, row_ang, col_ang):
    xf = x.astype(jnp.float32)
    out = jnp.concatenate([_rope_half(xf[..., :ROT_HALF], row_ang),
                           _rope_half(xf[..., ROT_HALF:], col_ang)], axis=-1)
    return out.astype(x.dtype)


def block_attention(q, k, v):
    B, L = q.shape[0], q.shape[1]
    n_blk = L // Q_BLOCK
    scale = 1.0 / math.sqrt(HEAD_DIM)
    qb = q.reshape(B, n_blk, Q_BLOCK, N_KV_HEADS, KV_REP, HEAD_DIM).transpose(1, 0, 2, 3, 4, 5)

    def attend_block(q_blk):
        s = jnp.einsum('bqgrd,bkgd->bgrqk', q_blk, k, preferred_element_type=jnp.float32) * scale
        pr = jax.nn.softmax(s, axis=-1).astype(v.dtype)
        return jnp.einsum('bgrqk,bkgd->bqgrd', pr, v)

    ob = lax.map(attend_block, qb)
    return ob.transpose(1, 0, 2, 3, 4, 5).reshape(B, L, Q_W)


def _lin_combine(e1, e2):
    a1, b1 = e1
    a2, b2 = e2
    return a1 * a2, a2 * b1 + b2


def _s5_scan(u, a_re, a_im, log_dt, b_re, b_im, c_re, c_im):
    lam = lax.complex(a_re, a_im)
    dt = jnp.exp(log_dt)[:, None]
    a_bar = jnp.exp(lam * dt)
    b_bar = ((a_bar - 1.0) / lam)[..., None] * lax.complex(b_re, b_im)
    bu = jnp.einsum('gpc,blgc->blgp', b_bar, u.astype(jnp.complex64))
    a_seq = jnp.broadcast_to(a_bar, (1, u.shape[1]) + a_bar.shape)
    _, state = lax.associative_scan(_lin_combine, (a_seq, bu), axis=1)
    return jnp.real(jnp.einsum('gcp,blgp->blgc', lax.complex(c_re, c_im), state))


def s5_branch(u_raw, a_re, a_im, log_dt, b_re, b_im, c_re, c_im, d_skip, w_glu, b_glu):
    B, L = u_raw.shape[0], u_raw.shape[1]
    f32 = jnp.float32
    u = u_raw.astype(f32).reshape(B, L, SSM_GROUPS, SSM_GROUP)
    y = d_skip.astype(f32).reshape(SSM_GROUPS, SSM_GROUP) * u
    for d in range(N_DIR):
        args = [t[d].astype(f32) for t in (a_re, a_im, log_dt, b_re, b_im, c_re, c_im)]
        if d == 0:
            y = y + _s5_scan(u, *args)
        else:
            y = y + jnp.flip(_s5_scan(jnp.flip(u, axis=1), *args), axis=1)
    y = jax.nn.gelu(y.reshape(B, L, SSM_WIDTH))
    y = y * jax.nn.sigmoid(y @ w_glu.astype(f32) + b_glu.astype(f32))
    return y.astype(u_raw.dtype)


def moe(xn, w_router, router_bias, w_exp_gate, w_exp_up, w_exp_down, w_sh_gate, w_sh_up, w_sh_down):
    B, L, D = xn.shape
    f32 = jnp.float32
    xf = xn.reshape(B * L, D)
    scores = jax.nn.sigmoid(jnp.dot(xf, w_router, preferred_element_type=f32))
    biased = scores + router_bias.astype(f32)
    grp = biased.reshape(-1, N_EXPERT_GROUPS, EXPERTS_PER_GROUP)
    grp_score = jnp.sum(lax.top_k(grp, 2)[0], axis=-1)
    _, grp_idx = lax.top_k(grp_score, TOPK_GROUPS)
    grp_mask = jnp.sum(jax.nn.one_hot(grp_idx, N_EXPERT_GROUPS, dtype=f32), axis=1)
    exp_mask = jnp.repeat(grp_mask, EXPERTS_PER_GROUP, axis=-1) > 0.0
    masked = jnp.where(exp_mask, biased, -1e30)
    _, top_idx = lax.top_k(masked, TOP_K)
    top_w = jnp.take_along_axis(scores, top_idx, axis=-1)
    top_w = top_w / jnp.sum(top_w, axis=-1, keepdims=True) * ROUTED_SCALE
    gates = jnp.einsum('nk,nke->en', top_w,
                       jax.nn.one_hot(top_idx, N_EXPERTS, dtype=f32)).astype(xn.dtype)

    def expert_step(acc, ew):
        wg, wu, wd, g = ew
        hid = jax.nn.silu(xf @ wg) * (xf @ wu)
        return acc + (hid * g[:, None]) @ wd, None

    routed, _ = lax.scan(expert_step, jnp.zeros_like(xf), (w_exp_gate, w_exp_up, w_exp_down, gates))
    shared = (jax.nn.silu(xf @ w_sh_gate) * (xf @ w_sh_up)) @ w_sh_down
    return (routed + shared).reshape(B, L, D)


def setup_inputs(seed: int = 0) -> dict:
    key = jax.random.key(seed)
    ks = jax.random.split(key, 40)
    nrm = jax.random.normal
    f32 = jnp.float32
    P, G, E, F = SSM_STATE, SSM_GROUPS, N_EXPERTS, EXPERT_DIM
    inp = {}
    inp['x'] = nrm(ks[0], (BATCH, SEQ, D_MODEL), f32)
    inp['p'] = nrm(ks[1], (DEPTH, BATCH, SEQ, PLE_DIM), f32)
    inp['g_mix'] = 1.0 + 0.02 * nrm(ks[2], (DEPTH, D_MODEL), f32)
    inp['w_in'] = nrm(ks[3], (DEPTH, D_MODEL, IN_WIDTH), f32) * D_MODEL ** -0.5
    inp['q_norm'] = 1.0 + 0.02 * nrm(ks[4], (DEPTH, HEAD_DIM), f32)
    inp['k_norm'] = 1.0 + 0.02 * nrm(ks[5], (DEPTH, HEAD_DIM), f32)
    inp['w_attn_up'] = nrm(ks[6], (DEPTH, Q_W, D_MODEL), f32) * Q_W ** -0.5
    inp['a_re'] = -0.5 + 0.01 * nrm(ks[7], (DEPTH, N_DIR, G, P), f32)
    inp['a_im'] = math.pi * jnp.arange(P, dtype=f32) + 0.01 * nrm(ks[8], (DEPTH, N_DIR, G, P), f32)
    inp['log_dt'] = jax.random.uniform(ks[9], (DEPTH, N_DIR, G), f32, math.log(1e-3), math.log(1e-1))
    inp['b_re'] = nrm(ks[10], (DEPTH, N_DIR, G, P, SSM_GROUP), f32) * (2 * SSM_GROUP) ** -0.5
    inp['b_im'] = nrm(ks[11], (DEPTH, N_DIR, G, P, SSM_GROUP), f32) * (2 * SSM_GROUP) ** -0.5
    inp['c_re'] = nrm(ks[12], (DEPTH, N_DIR, G, SSM_GROUP, P), f32) * (2 * P) ** -0.5
    inp['c_im'] = nrm(ks[13], (DEPTH, N_DIR, G, SSM_GROUP, P), f32) * (2 * P) ** -0.5
    inp['d_skip'] = nrm(ks[14], (DEPTH, SSM_WIDTH), f32)
    inp['w_glu'] = nrm(ks[15], (DEPTH, SSM_WIDTH, SSM_WIDTH), f32) * SSM_WIDTH ** -0.5
    inp['b_glu'] = 0.01 * nrm(ks[16], (DEPTH, SSM_WIDTH), f32)
    inp['w_ssm_up'] = nrm(ks[17], (DEPTH, SSM_WIDTH, D_MODEL), f32) * SSM_WIDTH ** -0.5
    inp['w_out'] = nrm(ks[18], (DEPTH, D_MODEL, D_MODEL), f32) * D_MODEL ** -0.5
    inp['g_ffn'] = 1.0 + 0.02 * nrm(ks[19], (DEPTH, D_MODEL), f32)
    inp['w_router'] = nrm(ks[20], (DEPTH, D_MODEL, E), f32) * D_MODEL ** -0.5
    inp['router_bias'] = 0.01 * nrm(ks[21], (DEPTH, E), f32)
    inp['w_exp_gate'] = nrm(ks[22], (DEPTH, E, D_MODEL, F), f32) * D_MODEL ** -0.5
    inp['w_exp_up'] = nrm(ks[23], (DEPTH, E, D_MODEL, F), f32) * D_MODEL ** -0.5
    inp['w_exp_down'] = nrm(ks[24], (DEPTH, E, F, D_MODEL), f32) * F ** -0.5
    inp['w_sh_gate'] = nrm(ks[25], (DEPTH, D_MODEL, SHARED_DIM), f32) * D_MODEL ** -0.5
    inp['w_sh_up'] = nrm(ks[26], (DEPTH, D_MODEL, SHARED_DIM), f32) * D_MODEL ** -0.5
    inp['w_sh_down'] = nrm(ks[27], (DEPTH, SHARED_DIM, D_MODEL), f32) * SHARED_DIM ** -0.5
    inp['g_ple'] = 1.0 + 0.02 * nrm(ks[28], (DEPTH, D_MODEL), f32)
    inp['w_ple_gate'] = nrm(ks[29], (DEPTH, D_MODEL, D_MODEL), f32) * D_MODEL ** -0.5
    inp['w_ple_proj'] = nrm(ks[30], (DEPTH, PLE_DIM, D_MODEL), f32) * PLE_DIM ** -0.5
    inp['g_final'] = 1.0 + 0.02 * nrm(ks[31], (D_MODEL,), f32)
    return inp


def reference(x, p, g_mix, w_in, q_norm, k_norm, w_attn_up, a_re, a_im, log_dt, b_re, b_im,
              c_re, c_im, d_skip, w_glu, b_glu, w_ssm_up, w_out, g_ffn, w_router, router_bias,
              w_exp_gate, w_exp_up, w_exp_down, w_sh_gate, w_sh_up, w_sh_down, g_ple,
              w_ple_gate, w_ple_proj, g_final):
    B, L, _ = x.shape
    f32 = jnp.float32
    ROWS = L // GRID_W
    row_ids = jnp.repeat(jnp.arange(ROWS, dtype=f32), GRID_W)
    col_ids = jnp.tile(jnp.arange(GRID_W, dtype=f32), ROWS)
    inv_freq = ROPE_THETA ** (-jnp.arange(0, ROT_HALF, 2, dtype=f32) / ROT_HALF)
    row_ang = row_ids[:, None] * inv_freq[None, :]
    col_ang = col_ids[:, None] * inv_freq[None, :]

    h = x
    for i in range(DEPTH):
        xn = rmsnorm(h, g_mix[i])
        proj = xn @ w_in[i]
        q, k, v, u, gate_a, gate_s = jnp.split(proj, IN_SPLITS, axis=-1)
        q = axial_rope(rmsnorm(q.reshape(B, L, N_HEADS, HEAD_DIM), q_norm[i]), row_ang, col_ang)
        k = axial_rope(rmsnorm(k.reshape(B, L, N_KV_HEADS, HEAD_DIM), k_norm[i]), row_ang, col_ang)
        v = v.reshape(B, L, N_KV_HEADS, HEAD_DIM)
        attn = block_attention(q, k, v)
        ssm = s5_branch(u, a_re[i], a_im[i], log_dt[i], b_re[i], b_im[i], c_re[i], c_im[i],
                        d_skip[i], w_glu[i], b_glu[i])
        merged = (jax.nn.sigmoid(gate_a) * (attn @ w_attn_up[i])
                  + jax.nn.sigmoid(gate_s) * (ssm @ w_ssm_up[i]))
        h = h + merged @ w_out[i]
        h = h + moe(rmsnorm(h, g_ffn[i]), w_router[i], router_bias[i], w_exp_gate[i], w_exp_up[i],
                    w_exp_down[i], w_sh_gate[i], w_sh_up[i], w_sh_down[i])
        ple_gate = jax.nn.sigmoid(rmsnorm(h, g_ple[i]) @ w_ple_gate[i])
        h = h + ple_gate * (p[i] @ w_ple_proj[i])
    return rmsnorm(h, g_final)
```

```cpp
#include <hip/hip_runtime.h>
#include <cstdio>
#include <cstdint>
#include <cmath>

constexpr int D_MODEL = 1024, BATCH = 32, SEQ = 2048, NTOK = BATCH * SEQ;
constexpr int N_HEADS = 8, N_KV = 2, HD = 64, Q_W = 512, KV_W = 128;
constexpr int SSM_W = 256, SSM_G = 16, SSM_NG = 16, SSM_P = 64;
constexpr int N_EXP = 64, EXP_D = 128, TOP_K = 8, N_EG = 8, TOPK_G = 4, EPG = 8, SH_D = 256;
constexpr int PLE_D = 256, IN_W = 3072;
constexpr float EPS = 1e-6f, ROUTED_SCALE = 2.5f;
constexpr float C2 = 0.125f * 1.4426950408889634f;
constexpr int CH_T = 64, NCHUNK = SEQ / CH_T;
constexpr int UCAT_LD = CH_T * SSM_G + 256;

typedef unsigned short bf16;
__device__ __forceinline__ bf16 f2bf(float f) { unsigned u = __builtin_bit_cast(unsigned, f); return (bf16)((u + 0x7fffu + ((u >> 16) & 1u)) >> 16); }
__device__ __forceinline__ float bf2f(bf16 h) { return __builtin_bit_cast(float, (unsigned)h << 16); }
__device__ __forceinline__ float sigmoidf_(float x) { return 1.f / (1.f + __expf(-x)); }
__device__ __forceinline__ float gelu_tanh(float x) { const float u = 0.7978845608028654f * (x + 0.044715f * x * x * x); return 0.5f * x * (1.f + tanhf(u)); }

constexpr size_t MiB = 1u << 20;
constexpr size_t WS_CTL = 0;
constexpr size_t WS_RSTD = 1 * MiB;
constexpr size_t WS_Q = 2 * MiB;
constexpr size_t WS_O = WS_Q + 64 * MiB;
constexpr size_t WS_K = WS_O + 64 * MiB;
constexpr size_t WS_V = WS_K + 16 * MiB;
constexpr size_t WS_UCAT = WS_V + 16 * MiB;
constexpr size_t WS_GA = WS_UCAT + 40 * MiB;
constexpr size_t WS_GS = WS_GA + 128 * MiB;
constexpr size_t WS_YACT = WS_GS + 128 * MiB;
constexpr size_t WS_XN3 = WS_YACT + 32 * MiB;
constexpr size_t WS_TMP = WS_XN3 + 128 * MiB;
constexpr size_t WS_TMP_BYTES = 1024 * MiB - WS_TMP;

template <class AL, class EP>
__global__ void __launch_bounds__(256) ngemm(AL al, EP ep, const int* Mz, const float* __restrict__ B, size_t strideB, int M, int N, int K, int ldb) {
    __shared__ float As[16][68];
    __shared__ float Bs[16][68];
    const int z = blockIdx.z;
    const int Mv = Mz ? Mz[z] : M;
    const int r0 = blockIdx.y * 64, c0 = blockIdx.x * 64;
    if (r0 >= Mv) return;
    const float* Bz = B + (size_t)z * strideB;
    const int tid = threadIdx.x, tx = tid & 15, ty = tid >> 4;
    float acc[4][4];
#pragma unroll
    for (int i = 0; i < 4; ++i)
#pragma unroll
        for (int j = 0; j < 4; ++j) acc[i][j] = 0.f;
    for (int k0 = 0; k0 < K; k0 += 16) {
#pragma unroll
        for (int i = 0; i < 4; ++i) {
            const int e = tid + i * 256, kk = e & 15, rr = e >> 4;
            const int r = r0 + rr;
            As[kk][rr] = (r < Mv) ? al.a(z, r, k0 + kk) : 0.f;
        }
#pragma unroll
        for (int i = 0; i < 4; ++i) {
            const int e = tid + i * 256, cc = e & 63, kk = e >> 6;
            Bs[kk][cc] = Bz[(size_t)(k0 + kk) * ldb + c0 + cc];
        }
        __syncthreads();
#pragma unroll
        for (int kk = 0; kk < 16; ++kk) {
            float a[4], b[4];
#pragma unroll
            for (int i = 0; i < 4; ++i) { a[i] = As[kk][ty * 4 + i]; b[i] = Bs[kk][tx * 4 + i]; }
#pragma unroll
            for (int i = 0; i < 4; ++i)
#pragma unroll
                for (int j = 0; j < 4; ++j) acc[i][j] += a[i] * b[j];
        }
        __syncthreads();
    }
#pragma unroll
    for (int i = 0; i < 4; ++i) {
        const int r = r0 + ty * 4 + i;
        if (r < Mv) {
#pragma unroll
            for (int j = 0; j < 4; ++j) ep.put(z, r, c0 + tx * 4 + j, acc[i][j]);
        }
    }
}
template <class AL, class EP>
static void launch_ngemm(hipStream_t s, int M, const int* Mz, int Mmax, int N, int K, int Z, AL al, const float* B, size_t strideB, int ldb, EP ep) {
    dim3 g(N / 64, (Mmax + 63) / 64, Z);
    hipLaunchKernelGGL((ngemm<AL, EP>), g, dim3(256), 0, s, al, ep, Mz, B, strideB, M, N, K, ldb);
}

struct AL_f32 { const float* A; int lda; int pad; __device__ float a(int, int r, int k) const { return A[(size_t)r * lda + k]; } };
struct AL_f32g { const float* A; const float* g; int lda; int pad; __device__ float a(int, int r, int k) const { return A[(size_t)r * lda + k] * g[k]; } };
struct AL_bf16 { const bf16* A; int lda; int pad; __device__ float a(int, int r, int k) const { return bf2f(A[(size_t)r * lda + k]); } };
struct AL_gather { const float* A; const int* list; int lda; int cap; __device__ float a(int z, int r, int k) const { return A[(size_t)list[(size_t)z * cap + r] * lda + k]; } };
struct AL_slot { const float* A; const int* base; int lda; int pad; __device__ float a(int z, int r, int k) const { return A[(size_t)(base[z] + r) * lda + k]; } };

__device__ __forceinline__ float wave_sum(float v) {
#pragma unroll
    for (int o = 1; o < 64; o <<= 1) v += __shfl_xor(v, o);
    return v;
}
__global__ void __launch_bounds__(256) k_rstd(const float* __restrict__ x, float* __restrict__ rstd, int rows) {
    const int row = blockIdx.x * 4 + (threadIdx.x >> 6), lane = threadIdx.x & 63;
    if (row >= rows) return;
    const float4* xr = (const float4*)(x + (size_t)row * D_MODEL);
    float s = 0.f;
#pragma unroll
    for (int j = 0; j < 4; ++j) { const float4 v = xr[lane + 64 * j]; s += v.x * v.x + v.y * v.y + v.z * v.z + v.w * v.w; }
    s = wave_sum(s);
    if (lane == 0) rstd[row] = rsqrtf(s * (1.f / D_MODEL) + EPS);
}
__global__ void __launch_bounds__(256) k_rownorm_f32(const float* __restrict__ x, const float* __restrict__ g, float* __restrict__ out, int rows) {
    const int row = blockIdx.x * 4 + (threadIdx.x >> 6), lane = threadIdx.x & 63;
    if (row >= rows) return;
    const float4* xr = (const float4*)(x + (size_t)row * D_MODEL);
    float4 v[4]; float s = 0.f;
#pragma unroll
    for (int j = 0; j < 4; ++j) { v[j] = xr[lane + 64 * j]; s += v[j].x * v[j].x + v[j].y * v[j].y + v[j].z * v[j].z + v[j].w * v[j].w; }
    const float r = rsqrtf(wave_sum(s) * (1.f / D_MODEL) + EPS);
    float4* o = (float4*)(out + (size_t)row * D_MODEL);
#pragma unroll
    for (int j = 0; j < 4; ++j) { const float4 gg = ((const float4*)g)[lane + 64 * j]; o[lane + 64 * j] = make_float4(v[j].x * r * gg.x, v[j].y * r * gg.y, v[j].z * r * gg.z, v[j].w * r * gg.w); }
}
__global__ void __launch_bounds__(256) k_combine(float* __restrict__ h, const float* __restrict__ acc, bf16* __restrict__ xn3, int rows) {
    const int row = blockIdx.x * 4 + (threadIdx.x >> 6), lane = threadIdx.x & 63;
    if (row >= rows) return;
    float4* hr = (float4*)(h + (size_t)row * D_MODEL);
    const float4* ar = (const float4*)(acc + (size_t)row * D_MODEL);
    float4 v[4]; float s = 0.f;
#pragma unroll
    for (int j = 0; j < 4; ++j) { const float4 a = hr[lane + 64 * j], b = ar[lane + 64 * j]; v[j] = make_float4(a.x + b.x, a.y + b.y, a.z + b.z, a.w + b.w);
        s += v[j].x * v[j].x + v[j].y * v[j].y + v[j].z * v[j].z + v[j].w * v[j].w; }
    const float r = rsqrtf(wave_sum(s) * (1.f / D_MODEL) + EPS);
#pragma unroll
    for (int j = 0; j < 4; ++j) { hr[lane + 64 * j] = v[j];
        bf16* o = xn3 + (size_t)row * D_MODEL + (lane + 64 * j) * 4;
        o[0] = f2bf(v[j].x * r); o[1] = f2bf(v[j].y * r); o[2] = f2bf(v[j].z * r); o[3] = f2bf(v[j].w * r); }
}

struct EP_inproj { const float* rstd; float* qk; bf16* V; bf16* ucat; bf16* ga; bf16* gs;
    __device__ void put(int, int r, int c, float acc) const {
        const float v = acc * rstd[r];
        if (c < 640) qk[(size_t)r * 640 + c] = v;
        else if (c < 768) V[(size_t)r * KV_W + (c - 640)] = f2bf(v);
        else if (c < 1024) { const int cu = c - 768, g = cu >> 4, ch = cu & 15, b = r / SEQ, t = r % SEQ;
            ucat[((size_t)g * (BATCH * NCHUNK) + b * NCHUNK + t / CH_T) * UCAT_LD + (t % CH_T) * SSM_G + ch] = f2bf(v); }
        else if (c < 2048) ga[(size_t)r * D_MODEL + (c - 1024)] = f2bf(sigmoidf_(v));
        else gs[(size_t)r * D_MODEL + (c - 2048)] = f2bf(sigmoidf_(v));
    } };
__global__ void __launch_bounds__(256) k_qknorm(const float* __restrict__ qk, const float* __restrict__ qn, const float* __restrict__ kn, bf16* __restrict__ Q, bf16* __restrict__ K) {
    const int idx = blockIdx.x * 256 + threadIdx.x;
    if (idx >= NTOK * 10) return;
    const int r = idx / 10, j = idx % 10;
    const float* src = qk + (size_t)r * 640 + j * 64;
    float y[64]; float s = 0.f;
#pragma unroll
    for (int d = 0; d < 64; ++d) { y[d] = src[d]; s += y[d] * y[d]; }
    const float rs = rsqrtf(s * (1.f / 64.f) + EPS);
    const float* w = (j < 8) ? qn : kn;
#pragma unroll
    for (int d = 0; d < 64; ++d) y[d] = y[d] * rs * w[d];
    const int pos = r % SEQ; const float row = (float)(pos / 64), col = (float)(pos % 64);
    float o[64];
#pragma unroll
    for (int i = 0; i < 16; ++i) {
        const float invf = powf(10000.f, -(float)(2 * i) / 32.f);
        float sr, cr, sc, cc; sincosf(row * invf, &sr, &cr); sincosf(col * invf, &sc, &cc);
        o[i] = y[i] * cr - y[i + 16] * sr; o[i + 16] = y[i + 16] * cr + y[i] * sr;
        o[32 + i] = y[32 + i] * cc - y[48 + i] * sc; o[48 + i] = y[48 + i] * cc + y[32 + i] * sc;
    }
    if (j < 8) { bf16* dst = Q + (size_t)r * Q_W + j * 64;
#pragma unroll
        for (int d = 0; d < 64; ++d) dst[d] = f2bf(o[d] * C2); }
    else { bf16* dst = K + (size_t)r * KV_W + (j - 8) * 64;
#pragma unroll
        for (int d = 0; d < 64; ++d) dst[d] = f2bf(o[d]); }
}

__global__ void __launch_bounds__(256) k_attn_naive(const bf16* __restrict__ Q, const bf16* __restrict__ K, const bf16* __restrict__ V, bf16* __restrict__ O) {
    const int qb = blockIdx.x & 7, h = (blockIdx.x >> 3) & 7, b = blockIdx.x >> 6;
    const int r = b * SEQ + qb * 256 + threadIdx.x, kvh = h / (N_HEADS / N_KV);
    float q[64], o[64];
#pragma unroll
    for (int d = 0; d < 64; ++d) { q[d] = bf2f(Q[(size_t)r * Q_W + h * 64 + d]); o[d] = 0.f; }
    float m = -INFINITY, l = 0.f;
    const bf16* Kb = K + (size_t)b * SEQ * KV_W + kvh * 64; const bf16* Vb = V + (size_t)b * SEQ * KV_W + kvh * 64;
    for (int j = 0; j < SEQ; ++j) {
        const bf16* kr = Kb + (size_t)j * KV_W; const bf16* vr = Vb + (size_t)j * KV_W;
        float s = 0.f;
#pragma unroll
        for (int d = 0; d < 64; ++d) s += q[d] * bf2f(kr[d]);
        if (s > m) { const float sc = exp2f(m - s); l *= sc;
#pragma unroll
            for (int d = 0; d < 64; ++d) o[d] *= sc;
            m = s; }
        const float p = exp2f(s - m); l += p;
#pragma unroll
        for (int d = 0; d < 64; ++d) o[d] += p * bf2f(vr[d]);
    }
    const float il = 1.f / l;
#pragma unroll
    for (int d = 0; d < 64; ++d) O[(size_t)r * Q_W + h * 64 + d] = f2bf(o[d] * il);
}

__global__ void __launch_bounds__(64) k_ssm_naive(const bf16* __restrict__ ucat, const float* __restrict__ a_re, const float* __restrict__ a_im, const float* __restrict__ log_dt,
                                                  const float* __restrict__ b_re, const float* __restrict__ b_im, const float* __restrict__ c_re, const float* __restrict__ c_im,
                                                  const float* __restrict__ d_skip, float* __restrict__ ytmp, bf16* __restrict__ yact) {
    const int g = blockIdx.x & 15, b = blockIdx.x >> 4, p = threadIdx.x;
    for (int dir = 0; dir < 2; ++dir) {
        const int gi = dir * SSM_NG + g;
        const float are = a_re[gi * SSM_P + p], aim = a_im[gi * SSM_P + p], dt = expf(log_dt[gi]);
        const float mag = expf(are * dt); float sn, cs; sincosf(aim * dt, &sn, &cs);
        const float abr = mag * cs, abi = mag * sn;
        const float nr = abr - 1.f, ni = abi, den = are * are + aim * aim;
        const float cfr = (nr * are + ni * aim) / den, cfi = (ni * are - nr * aim) / den;
        float bbr[16], bbi[16], cr[16], ci[16];
#pragma unroll
        for (int c = 0; c < 16; ++c) {
            const float br = b_re[((size_t)gi * SSM_P + p) * SSM_G + c], bi = b_im[((size_t)gi * SSM_P + p) * SSM_G + c];
            bbr[c] = cfr * br - cfi * bi; bbi[c] = cfr * bi + cfi * br;
            cr[c] = c_re[((size_t)gi * SSM_G + c) * SSM_P + p]; ci[c] = c_im[((size_t)gi * SSM_G + c) * SSM_P + p];
        }
        float sr = 0.f, si = 0.f;
        for (int tt = 0; tt < SEQ; ++tt) {
            const int t = dir ? (SEQ - 1 - tt) : tt;
            const bf16* up = ucat + ((size_t)g * (BATCH * NCHUNK) + b * NCHUNK + t / CH_T) * UCAT_LD + (t % CH_T) * SSM_G;
            float u[16]; float bur = 0.f, bui = 0.f;
#pragma unroll
            for (int c = 0; c < 16; ++c) { u[c] = bf2f(up[c]); bur += bbr[c] * u[c]; bui += bbi[c] * u[c]; }
            const float nsr = abr * sr - abi * si + bur, nsi = abr * si + abi * sr + bui; sr = nsr; si = nsi;
            float mine = 0.f;
#pragma unroll
            for (int c = 0; c < 16; ++c) { const float v = wave_sum(cr[c] * sr - ci[c] * si); if (p == c) mine = v; }
            if (p < 16) {
                const size_t oi = ((size_t)b * SEQ + t) * SSM_W + g * SSM_G + p;
                float up_ = 0.f;
#pragma unroll
                for (int c = 0; c < 16; ++c) if (p == c) up_ = u[c];
                if (dir == 0) ytmp[oi] = mine + d_skip[g * SSM_G + p] * up_;
                else yact[oi] = f2bf(gelu_tanh(ytmp[oi] + mine));
            }
        }
    }
}

struct EP_glu { const bf16* yact; const float* bglu; float* ssm; int row0; int pad;
    __device__ void put(int, int r, int c, float acc) const { const float y = bf2f(yact[(size_t)(row0 + r) * SSM_W + c]); ssm[(size_t)r * SSM_W + c] = y * sigmoidf_(acc + bglu[c]); } };
struct EP_gate_set { const bf16* gate; float* t; int row0; int pad;
    __device__ void put(int, int r, int c, float acc) const { t[(size_t)r * D_MODEL + c] = bf2f(gate[(size_t)(row0 + r) * D_MODEL + c]) * acc; } };
struct EP_gate_add { const bf16* gate; float* t; int row0; int pad;
    __device__ void put(int, int r, int c, float acc) const { t[(size_t)r * D_MODEL + c] += bf2f(gate[(size_t)(row0 + r) * D_MODEL + c]) * acc; } };
struct EP_resid { const float* x; float* out;
    __device__ void put(int, int r, int c, float acc) const { out[(size_t)r * D_MODEL + c] = x[(size_t)r * D_MODEL + c] + acc; } };

struct EP_sigmoid { float* o; int ld; int pad; __device__ void put(int, int r, int c, float acc) const { o[(size_t)r * ld + c] = sigmoidf_(acc); } };
struct EP_store { float* o; int ld; int pad; __device__ void put(int, int r, int c, float acc) const { o[(size_t)r * ld + c] = acc; } };
struct EP_add { float* o; int ld; int pad; __device__ void put(int, int r, int c, float acc) const { o[(size_t)r * ld + c] += acc; } };
struct EP_silu_mul { const float* g; float* o; int ld; int pad; __device__ void put(int, int r, int c, float acc) const { const float gv = g[(size_t)r * ld + c]; o[(size_t)r * ld + c] = gv * sigmoidf_(gv) * acc; } };
struct EP_slot_store { float* o; const int* base; __device__ void put(int z, int r, int c, float acc) const { o[(size_t)(base[z] + r) * EXP_D + c] = acc; } };
struct EP_slot_silu { float* o; const int* base; const float* w; int cap; int pad;
    __device__ void put(int z, int r, int c, float acc) const { float* e = o + (size_t)(base[z] + r) * EXP_D + c; const float gv = *e; *e = gv * sigmoidf_(gv) * acc * w[(size_t)z * cap + r]; } };
struct EP_scatter_add { float* acc_; const int* list; int cap; int pad;
    __device__ void put(int z, int r, int c, float acc) const { atomicAdd(acc_ + (size_t)list[(size_t)z * cap + r] * D_MODEL + c, acc); } };

__global__ void __launch_bounds__(256) k_route(const float* __restrict__ scores, const float* __restrict__ rbias, int* __restrict__ cnt, int* __restrict__ list, float* __restrict__ listw, int rows, int cap) {
    const int t = blockIdx.x * 256 + threadIdx.x;
    if (t >= rows) return;
    float s[64], bsd[64];
#pragma unroll
    for (int e = 0; e < 64; ++e) { s[e] = scores[(size_t)t * 64 + e]; bsd[e] = s[e] + rbias[e]; }
    float gs[8];
#pragma unroll
    for (int g = 0; g < 8; ++g) { float m1 = -INFINITY, m2 = -INFINITY;
#pragma unroll
        for (int j = 0; j < 8; ++j) { const float v = bsd[g * 8 + j]; if (v > m1) { m2 = m1; m1 = v; } else if (v > m2) m2 = v; }
        gs[g] = m1 + m2; }
    unsigned gmask = 0;
#pragma unroll
    for (int k = 0; k < TOPK_G; ++k) { int best = -1; float bv = -INFINITY;
#pragma unroll
        for (int g = 0; g < 8; ++g) if (!((gmask >> g) & 1u) && gs[g] > bv) { bv = gs[g]; best = g; }
        gmask |= 1u << best; }
    unsigned long long emask = 0ull; int idx[8]; float wsum = 0.f;
#pragma unroll
    for (int k = 0; k < TOP_K; ++k) { int best = -1; float bv = -INFINITY;
#pragma unroll
        for (int e = 0; e < 64; ++e) { const bool ok = ((gmask >> (e >> 3)) & 1u) && !((emask >> e) & 1ull); if (ok && bsd[e] > bv) { bv = bsd[e]; best = e; } }
        emask |= 1ull << best; idx[k] = best; }
#pragma unroll
    for (int k = 0; k < 8; ++k) { float sv = 0.f;
#pragma unroll
        for (int e = 0; e < 64; ++e) if (e == idx[k]) sv = s[e];
        wsum += sv; }
#pragma unroll
    for (int k = 0; k < 8; ++k) { float sv = 0.f;
#pragma unroll
        for (int e = 0; e < 64; ++e) if (e == idx[k]) sv = s[e];
        const int e = idx[k]; const int pos = atomicAdd(cnt + e, 1);
        list[(size_t)e * cap + pos] = t; listw[(size_t)e * cap + pos] = sv / wsum * ROUTED_SCALE; }
}
__global__ void k_prefix(const int* __restrict__ cnt, int* __restrict__ base) { if (threadIdx.x == 0) { int s = 0; for (int e = 0; e < 64; ++e) { base[e] = s; s += cnt[e]; } } }

struct EP_ple { float* h; const float* pp;
    __device__ void put(int, int r, int c, float acc) const { float* e = h + (size_t)r * D_MODEL + c; *e = *e + sigmoidf_(acc) * pp[(size_t)r * D_MODEL + c]; } };
__global__ void __launch_bounds__(256) k_final(float* __restrict__ h, const float* __restrict__ g, int rows) {
    const int row = blockIdx.x * 4 + (threadIdx.x >> 6), lane = threadIdx.x & 63;
    if (row >= rows) return;
    float4* hr = (float4*)(h + (size_t)row * D_MODEL);
    float4 v[4]; float s = 0.f;
#pragma unroll
    for (int j = 0; j < 4; ++j) { v[j] = hr[lane + 64 * j]; s += v[j].x * v[j].x + v[j].y * v[j].y + v[j].z * v[j].z + v[j].w * v[j].w; }
    const float r = rsqrtf(wave_sum(s) * (1.f / D_MODEL) + EPS);
#pragma unroll
    for (int j = 0; j < 4; ++j) { const float4 gg = ((const float4*)g)[lane + 64 * j]; hr[lane + 64 * j] = make_float4(v[j].x * r * gg.x, v[j].y * r * gg.y, v[j].z * r * gg.z, v[j].w * r * gg.w); }
}

extern "C" void kernel_launch(void* const* d_in, const int* in_sizes, int n_in, void* d_out, int out_size, void* d_ws, size_t ws_size, hipStream_t stream) {
    (void)in_sizes; (void)n_in; (void)out_size;
    if (ws_size < 1024 * MiB) { fprintf(stderr, "kernel_launch: workspace too small (%zu)\n", ws_size); return; }
    const float* x = (const float*)d_in[0]; const float* p = (const float*)d_in[1]; const float* g_mix = (const float*)d_in[2]; const float* w_in = (const float*)d_in[3];
    const float* q_norm = (const float*)d_in[4]; const float* k_norm = (const float*)d_in[5]; const float* w_attn_up = (const float*)d_in[6];
    const float* a_re = (const float*)d_in[7]; const float* a_im = (const float*)d_in[8]; const float* log_dt = (const float*)d_in[9];
    const float* b_re = (const float*)d_in[10]; const float* b_im = (const float*)d_in[11]; const float* c_re = (const float*)d_in[12]; const float* c_im = (const float*)d_in[13];
    const float* d_skip = (const float*)d_in[14]; const float* w_glu = (const float*)d_in[15]; const float* b_glu = (const float*)d_in[16]; const float* w_ssm_up = (const float*)d_in[17];
    const float* w_out = (const float*)d_in[18]; const float* g_ffn = (const float*)d_in[19]; const float* w_router = (const float*)d_in[20]; const float* router_bias = (const float*)d_in[21];
    const float* w_exp_gate = (const float*)d_in[22]; const float* w_exp_up = (const float*)d_in[23]; const float* w_exp_down = (const float*)d_in[24];
    const float* w_sh_gate = (const float*)d_in[25]; const float* w_sh_up = (const float*)d_in[26]; const float* w_sh_down = (const float*)d_in[27];
    const float* g_ple = (const float*)d_in[28]; const float* w_ple_gate = (const float*)d_in[29]; const float* w_ple_proj = (const float*)d_in[30]; const float* g_final = (const float*)d_in[31];
    float* out = (float*)d_out; char* ws = (char*)d_ws;
    float* rstd1 = (float*)(ws + WS_RSTD);
    bf16* Qb = (bf16*)(ws + WS_Q); bf16* Ob = (bf16*)(ws + WS_O); bf16* Kb = (bf16*)(ws + WS_K); bf16* Vb = (bf16*)(ws + WS_V);
    bf16* ucat = (bf16*)(ws + WS_UCAT); bf16* GA = (bf16*)(ws + WS_GA); bf16* GS = (bf16*)(ws + WS_GS); bf16* yact = (bf16*)(ws + WS_YACT); bf16* xn3 = (bf16*)(ws + WS_XN3);
    char* tmp = ws + WS_TMP;

    {
        float* qk = (float*)tmp;
        hipLaunchKernelGGL(k_rstd, dim3(NTOK / 4), dim3(256), 0, stream, x, rstd1, NTOK);
        launch_ngemm(stream, NTOK, nullptr, NTOK, IN_W, D_MODEL, 1, AL_f32g{x, g_mix, D_MODEL, 0}, w_in, 0, IN_W, EP_inproj{rstd1, qk, Vb, ucat, GA, GS});
        hipLaunchKernelGGL(k_qknorm, dim3((NTOK * 10 + 255) / 256), dim3(256), 0, stream, qk, q_norm, k_norm, Qb, Kb);
    }
    hipLaunchKernelGGL(k_attn_naive, dim3(BATCH * N_HEADS * (SEQ / 256)), dim3(256), 0, stream, Qb, Kb, Vb, Ob);
    {
        float* ytmp = (float*)tmp;
        hipLaunchKernelGGL(k_ssm_naive, dim3(BATCH * SSM_NG), dim3(64), 0, stream, ucat, a_re, a_im, log_dt, b_re, b_im, c_re, c_im, d_skip, ytmp, yact);
    }
    constexpr int NC = 4, RC = NTOK / NC;
    for (int ch = 0; ch < NC; ++ch) {
        const int row0 = ch * RC;
        float* t_ssm = (float*)tmp;
        float* t_mrg = (float*)(tmp + 16 * MiB);
        launch_ngemm(stream, RC, nullptr, RC, SSM_W, SSM_W, 1, AL_bf16{yact + (size_t)row0 * SSM_W, SSM_W, 0}, w_glu, 0, SSM_W, EP_glu{yact, b_glu, t_ssm, row0, 0});
        launch_ngemm(stream, RC, nullptr, RC, D_MODEL, Q_W, 1, AL_bf16{Ob + (size_t)row0 * Q_W, Q_W, 0}, w_attn_up, 0, D_MODEL, EP_gate_set{GA, t_mrg, row0, 0});
        launch_ngemm(stream, RC, nullptr, RC, D_MODEL, SSM_W, 1, AL_f32{t_ssm, SSM_W, 0}, w_ssm_up, 0, D_MODEL, EP_gate_add{GS, t_mrg, row0, 0});
        launch_ngemm(stream, RC, nullptr, RC, D_MODEL, D_MODEL, 1, AL_f32{t_mrg, D_MODEL, 0}, w_out, 0, D_MODEL, EP_resid{x + (size_t)row0 * D_MODEL, out + (size_t)row0 * D_MODEL});
        float* h = out + (size_t)row0 * D_MODEL;
        float* xn2 = (float*)(tmp + 16 * MiB);
        float* acc = (float*)(tmp + 80 * MiB);
        float* sc = (float*)(tmp + 144 * MiB);
        float* hid = (float*)(tmp + 148 * MiB);
        float* shg = (float*)(tmp + 212 * MiB);
        int* list = (int*)(tmp + 228 * MiB);
        float* listw = (float*)(tmp + 232 * MiB);
        int* cnt = (int*)(tmp + 236 * MiB); int* base = cnt + 64;
        hipLaunchKernelGGL(k_rownorm_f32, dim3(RC / 4), dim3(256), 0, stream, h, g_ffn, xn2, RC);
        launch_ngemm(stream, RC, nullptr, RC, N_EXP, D_MODEL, 1, AL_f32{xn2, D_MODEL, 0}, w_router, 0, N_EXP, EP_sigmoid{sc, N_EXP, 0});
        (void)hipMemsetAsync(cnt, 0, 512, stream);
        (void)hipMemsetAsync(acc, 0, (size_t)RC * D_MODEL * 4, stream);
        hipLaunchKernelGGL(k_route, dim3(RC / 256), dim3(256), 0, stream, sc, router_bias, cnt, list, listw, RC, RC);
        hipLaunchKernelGGL(k_prefix, dim3(1), dim3(64), 0, stream, cnt, base);
        launch_ngemm(stream, 0, cnt, RC, EXP_D, D_MODEL, N_EXP, AL_gather{xn2, list, D_MODEL, RC}, w_exp_gate, (size_t)D_MODEL * EXP_D, EXP_D, EP_slot_store{hid, base});
        launch_ngemm(stream, 0, cnt, RC, EXP_D, D_MODEL, N_EXP, AL_gather{xn2, list, D_MODEL, RC}, w_exp_up, (size_t)D_MODEL * EXP_D, EXP_D, EP_slot_silu{hid, base, listw, RC, 0});
        launch_ngemm(stream, 0, cnt, RC, D_MODEL, EXP_D, N_EXP, AL_slot{hid, base, EXP_D, 0}, w_exp_down, (size_t)EXP_D * D_MODEL, D_MODEL, EP_scatter_add{acc, list, RC, 0});
        launch_ngemm(stream, RC, nullptr, RC, SH_D, D_MODEL, 1, AL_f32{xn2, D_MODEL, 0}, w_sh_gate, 0, SH_D, EP_store{shg, SH_D, 0});
        launch_ngemm(stream, RC, nullptr, RC, SH_D, D_MODEL, 1, AL_f32{xn2, D_MODEL, 0}, w_sh_up, 0, SH_D, EP_silu_mul{shg, shg, SH_D, 0});
        launch_ngemm(stream, RC, nullptr, RC, D_MODEL, SH_D, 1, AL_f32{shg, SH_D, 0}, w_sh_down, 0, D_MODEL, EP_add{acc, D_MODEL, 0});
        hipLaunchKernelGGL(k_combine, dim3(RC / 4), dim3(256), 0, stream, h, acc, xn3 + (size_t)row0 * D_MODEL, RC);
        float* xn3f = (float*)(tmp + 16 * MiB);
        float* pp = (float*)(tmp + 80 * MiB);
        hipLaunchKernelGGL(k_rownorm_f32, dim3(RC / 4), dim3(256), 0, stream, h, g_ple, xn3f, RC);
        launch_ngemm(stream, RC, nullptr, RC, D_MODEL, PLE_D, 1, AL_f32{p + (size_t)row0 * PLE_D, PLE_D, 0}, w_ple_proj, 0, D_MODEL, EP_store{pp, D_MODEL, 0});
        launch_ngemm(stream, RC, nullptr, RC, D_MODEL, D_MODEL, 1, AL_f32{xn3f, D_MODEL, 0}, w_ple_gate, 0, D_MODEL, EP_ple{h, pp});
        hipLaunchKernelGGL(k_final, dim3(RC / 4), dim3(256), 0, stream, h, g_final, RC);
    }
}
```

```cpp
#include <hip/hip_runtime.h>
#include <cstdio>
#include <cstdint>
#include <cmath>

constexpr int D_MODEL = 1024, BATCH = 32, SEQ = 2048, NTOK = BATCH * SEQ;
constexpr int N_HEADS = 8, N_KV = 2, HD = 64, Q_W = 512, KV_W = 128;
constexpr int SSM_W = 256, SSM_G = 16, SSM_NG = 16, SSM_P = 64;
constexpr int N_EXP = 64, EXP_D = 128, TOP_K = 8, N_EG = 8, TOPK_G = 4, EPG = 8, SH_D = 256;
constexpr int PLE_D = 256, IN_W = 3072;
constexpr float EPS = 1e-6f, ROUTED_SCALE = 2.5f;
constexpr float C2 = 0.125f * 1.4426950408889634f;
constexpr int CH_T = 64, NCHUNK = SEQ / CH_T;
constexpr int UCAT_LD = CH_T * SSM_G + 256;

#define GAS __attribute__((address_space(1)))
#define LAS __attribute__((address_space(3)))
typedef unsigned short bf16;
typedef unsigned v4u __attribute__((ext_vector_type(4)));
typedef unsigned v2u __attribute__((ext_vector_type(2)));
typedef float f32x4 __attribute__((ext_vector_type(4)));
typedef float f32x2 __attribute__((ext_vector_type(2)));
typedef short bf16x8 __attribute__((ext_vector_type(8)));
typedef GAS unsigned gu32;
#define RLX_AGENT __ATOMIC_RELAXED, __HIP_MEMORY_SCOPE_AGENT
#define LDS_WAIT() asm volatile("s_waitcnt lgkmcnt(0)" ::: "memory")
#define VM_WAIT() asm volatile("s_waitcnt vmcnt(0)" ::: "memory")
__device__ __forceinline__ bf16 f2bf(float f) { unsigned u = __builtin_bit_cast(unsigned, f); return (bf16)((u + 0x7fffu + ((u >> 16) & 1u)) >> 16); }
__device__ __forceinline__ float bf2f(bf16 h) { return __builtin_bit_cast(float, (unsigned)h << 16); }
__device__ __forceinline__ unsigned pk2(float lo, float hi) { return (unsigned)f2bf(lo) | ((unsigned)f2bf(hi) << 16); }
typedef __bf16 bf16x2_t __attribute__((ext_vector_type(2)));
__device__ __forceinline__ unsigned cvt_pk_bf16(float lo, float hi) { f32x2 v = {lo, hi}; bf16x2_t b = __builtin_convertvector(v, bf16x2_t); return __builtin_bit_cast(unsigned, b); }
__device__ __forceinline__ float sigmoidf_(float x) { return 1.f / (1.f + __expf(-x)); }
__device__ __forceinline__ float fsig(float x) { return __builtin_amdgcn_rcpf(1.f + __builtin_amdgcn_exp2f(-1.4426950408889634f * x)); }
__device__ __forceinline__ float gelu_tanh(float x) { const float u = 0.7978845608028654f * (x + 0.044715f * x * x * x); return 0.5f * x * (1.f + tanhf(u)); }
__device__ __forceinline__ float wave_sum(float v) {
#pragma unroll
    for (int o = 1; o < 64; o <<= 1) v += __shfl_xor(v, o);
    return v;
}

constexpr size_t MiB = 1u << 20;
constexpr size_t WS_CTL = 0;
constexpr size_t WS_RSTD1 = 1 * MiB;
constexpr size_t WS_RSTD2 = WS_RSTD1 + 256 * 1024;
constexpr size_t WS_ROPE = WS_RSTD2 + 256 * 1024;
constexpr size_t WS_IDENT = WS_ROPE + 256 * 1024;
constexpr size_t WS_WIN = 2 * MiB;
constexpr size_t WS_WAU = WS_WIN + 6 * MiB;
constexpr size_t WS_WSU = WS_WAU + 1 * MiB;
constexpr size_t WS_WGLU = WS_WSU + 512 * 1024;
constexpr size_t WS_WOUT = WS_WGLU + 512 * 1024;
constexpr size_t WS_WEGU = WS_WOUT + 2 * MiB;
constexpr size_t WS_WED = WS_WEGU + 32 * MiB;
constexpr size_t WS_WSGU = WS_WED + 16 * MiB;
constexpr size_t WS_WSD = WS_WSGU + 1 * MiB;
constexpr size_t WS_WPG = WS_WSD + 512 * 1024;
constexpr size_t WS_WPP = WS_WPG + 2 * MiB;
constexpr size_t WS_BTCAT = WS_WPP + 512 * 1024;
constexpr size_t WS_BTST = WS_BTCAT + 40 * MiB;
constexpr size_t WS_WROUTER = WS_BTST + 8 * MiB;
constexpr size_t WS_WEND = WS_WROUTER + 512 * 1024;
static_assert(WS_WEND <= 114 * MiB, "weights region");
constexpr size_t WS_Q = 114 * MiB;
constexpr size_t WS_O = WS_Q + 64 * MiB;
constexpr size_t WS_K = WS_O + 64 * MiB;
constexpr size_t WS_V = WS_K + 16 * MiB;
constexpr size_t WS_UCAT = WS_V + 16 * MiB;
constexpr size_t WS_GA = WS_UCAT + 40 * MiB;
constexpr size_t WS_GS = WS_GA + 128 * MiB;
constexpr size_t WS_YACT = WS_GS + 128 * MiB;
constexpr size_t WS_XB = WS_YACT + 32 * MiB;
constexpr size_t WS_TMP = WS_XB + 128 * MiB;
constexpr size_t WS_TMP_BYTES = 1024 * MiB - WS_TMP;
static_assert(WS_TMP_BYTES >= 240 * MiB, "naive temporaries");
constexpr size_t WS_LST = WS_TMP;

constexpr size_t WS_XN2 = 114 * MiB;
constexpr size_t WS_XN3 = WS_XN2;
constexpr size_t WS_HID = WS_XN2 + 128 * MiB;
constexpr size_t WS_HSH = WS_HID + 132 * MiB;
constexpr size_t WS_LTOK = WS_HSH + 32 * MiB;
constexpr size_t WS_LW = WS_LTOK + 16 * MiB;
constexpr size_t WS_LROW = WS_LW + 16 * MiB;
constexpr size_t WS_LOGIT = WS_LROW + 16 * MiB;
constexpr size_t WS_YSLOT = WS_LOGIT + 32 * MiB;
static_assert(WS_YSLOT + 512 * MiB <= 1024 * MiB, "workspace");
namespace pg8 {
#define PG8_LAS __attribute__((address_space(3)))
typedef unsigned short bf16_t;
typedef unsigned u32x4 __attribute__((ext_vector_type(4)));
constexpr int BM = 256, BK = 64, HALF = 128, HTB = HALF * BK * 2  , STAGE_BYTES = 8 * HTB, NXCD = 8, WGM = 8;
__host__ __device__ __forceinline__ int lds_byte(int r, int c) { const int st = (r >> 4) * 2 + (c >> 5), rr = r & 15, cc = c & 31, ob = rr * 64 + cc * 2; return st * 1024 + (ob ^ (((ob >> 9) & 1) << 5)); }
__host__ __device__ __forceinline__ void stage_rc(int b, int& R, int& C) { const int st = b / 1024, sb = b % 1024, swz = sb ^ (((sb >> 9) & 1) << 5); R = (st >> 1) * 16 + swz / 64; C = (st & 1) * 32 + (swz % 64) / 2; }
__host__ __device__ __forceinline__ int perm32(int rho) { const int n = rho >> 4, i = rho & 15; return 8 * (i >> 2) + 4 * n + (i & 3); }

struct Unit { int pm, pn; const char* A; const char* B; const int* rows; int nrows; int aux; };
struct Desc { int K; unsigned lda2, ldb2; };

__device__ __forceinline__ bool static_tile(int nM, int nN, int G, int c, int i, int& pm, int& pn) {
    const int nwg = nM * nN; const long L = (long)i * G + c; if (L >= nwg) return false;
    int wgid = (int)L; { const int q = nwg / NXCD, r = nwg % NXCD, xcd = wgid % NXCD, off = wgid / NXCD; wgid = (xcd < r ? xcd * (q + 1) : r * (q + 1) + (xcd - r) * q) + off; }
    const int nig = WGM * nN, gid = wgid / nig, fm = gid * WGM, gsz = (nM - fm) < WGM ? (nM - fm) : WGM;
    pm = fm + ((wgid % nig) % gsz); pn = (wgid % nig) / gsz; return true;
}
struct PlainOrder {
    const char* A; const char* B; int nM, nN, G, c; unsigned lda2, ldb2;
    __device__ __forceinline__ bool next(int i, Unit& u) const {
        if (!static_tile(nM, nN, G, c, i, u.pm, u.pn)) return false;
        u.A = A + (size_t)u.pm * BM * lda2; u.B = B + (size_t)u.pn * BM * ldb2; u.rows = nullptr; u.nrows = BM; u.aux = 0; return true; }
};

template <class Epi, class Sched, bool ALIGN_EPI, bool GATHER>
__device__ __forceinline__ void gemm_run(PG8_LAS unsigned char* lds, const Desc g, const Sched& S, const Epi& E) {
    int tid = threadIdx.x; asm volatile("" : "+v"(tid));
    const int wid = __builtin_amdgcn_readfirstlane(tid >> 6), lane = tid & 63, wr = wid >> 2, wc = wid & 3, fr = lane & 15, fq = lane >> 4;
    const int nt = g.K / BK;
    int R[2], C[2]; unsigned voffB[2], voffA[2][2], nvoffA[2][2];
#pragma unroll
    for (int i = 0; i < 2; ++i) { stage_rc(tid * 16 + i * 8192, R[i], C[i]); const int Rb = Epi::PERM ? ((R[i] & ~31) + perm32(R[i] & 31)) : R[i];
        voffB[i] = (unsigned)Rb * g.ldb2 + (unsigned)C[i] * 2u; }
    const size_t kstep = (size_t)(BK * 2);
    const size_t hstepB = (size_t)HALF * g.ldb2;
    const unsigned ldsw = (unsigned)wid * 1024u;
    const int aoff = lds_byte(wr * 64 + fr, fq * 8), boff = lds_byte(wc * 32 + fr, fq * 8);
    unsigned bbv[2][2];
#pragma unroll
    for (int b = 0; b < 2; ++b)
#pragma unroll
        for (int h = 0; h < 2; ++h) { bbv[b][h] = (unsigned)(boff + (4 + b * 2 + h) * HTB); asm volatile("" : "+v"(bbv[b][h])); }
#define PG8_SA(b, h) (((b) * 2 + (h)) * HTB)
#define PG8_SB(b, h) ((4 + (b) * 2 + (h)) * HTB)
#define PG8_STAGE(bufoff, gbase, voff) do { _Pragma("unroll") for (int _i = 0; _i < 2; ++_i) \
        __builtin_amdgcn_global_load_lds((const unsigned*)((const char*)(gbase) + (voff)[_i]), (PG8_LAS unsigned*)(lds + (bufoff) + ldsw + _i * 8192), 16, 0, 0); } while (0)
#define PG8_LDA(dst, b, h) do { _Pragma("unroll") for (int m = 0; m < 4; ++m) _Pragma("unroll") for (int k = 0; k < 2; ++k) dst[m][k] = *(const PG8_LAS bf16x8*)(lds + PG8_SA(b, h) + aoff + m * 2048 + k * 1024); } while (0)
#define PG8_LDB(dst, b, h) do { _Pragma("unroll") for (int n = 0; n < 2; ++n) _Pragma("unroll") for (int k = 0; k < 2; ++k) dst[n][k] = *(const PG8_LAS bf16x8*)(lds + bbv[b][h] + n * 2048 + k * 1024); } while (0)
#define PG8_MMA(ai, bj, At, Bt) do { __builtin_amdgcn_s_setprio(1); _Pragma("unroll") for (int m = 0; m < 4; ++m) _Pragma("unroll") for (int n = 0; n < 2; ++n) _Pragma("unroll") for (int k = 0; k < 2; ++k) \
        acc[ai][bj][m][n] = __builtin_amdgcn_mfma_f32_16x16x32_bf16(Bt[n][k], At[m][k], acc[ai][bj][m][n], 0, 0, 0); __builtin_amdgcn_s_setprio(0); } while (0)
#define PG8_WAIT_V(n) asm volatile("s_waitcnt vmcnt(" #n ")" ::: "memory")
#define PG8_WAIT_L(n) asm volatile("s_waitcnt lgkmcnt(" #n ")" ::: "memory")
#define PG8_BAR __builtin_amdgcn_s_barrier()
#define PG8_SCHED __builtin_amdgcn_sched_barrier(0)
#define PG8_SETVA(dst, un) do { _Pragma("unroll") for (int h = 0; h < 2; ++h) _Pragma("unroll") for (int i = 0; i < 2; ++i) { \
        if constexpr (GATHER) { int rr = h * HALF + R[i]; rr = rr < (un).nrows ? rr : (un).nrows - 1; dst[h][i] = (unsigned)(un).rows[rr] * g.lda2 + (unsigned)C[i] * 2u; } \
        else dst[h][i] = (unsigned)(h * HALF + R[i]) * g.lda2 + (unsigned)C[i] * 2u; } } while (0)
    Unit cur, nxt; int ui = 0;
    if (!S.next(0, cur)) return;
    PG8_SETVA(voffA, cur);
    f32x4 acc[2][2][4][2];
#pragma unroll
    for (int a = 0; a < 2; ++a)
#pragma unroll
        for (int b = 0; b < 2; ++b)
#pragma unroll
            for (int m = 0; m < 4; ++m)
#pragma unroll
                for (int n = 0; n < 2; ++n) acc[a][b][m][n] = (f32x4){0.f, 0.f, 0.f, 0.f};
    bf16x8 At[4][2], B0[2][2], B1[2][2];
    const char* cA = cur.A; const char* cB = cur.B;
    PG8_STAGE(PG8_SB(0, 0), cB, voffB); PG8_STAGE(PG8_SB(0, 1), cB + hstepB, voffB); PG8_STAGE(PG8_SA(0, 0), cA, voffA[0]); PG8_STAGE(PG8_SA(0, 1), cA, voffA[1]);
    if (wr == 1) PG8_BAR;
    PG8_WAIT_V(2); PG8_BAR;
    PG8_STAGE(PG8_SB(1, 0), cB + kstep, voffB); PG8_STAGE(PG8_SA(1, 0), cA + kstep, voffA[0]); PG8_STAGE(PG8_SB(1, 1), cB + hstepB + kstep, voffB);
    PG8_WAIT_V(6); PG8_BAR;
    for (;;) {
        const bool has_next = S.next(ui + 1, nxt);
        const char* nA = has_next ? nxt.A : cA; const char* nB = has_next ? nxt.B : cB;
        if constexpr (GATHER) { if (has_next) { PG8_SETVA(nvoffA, nxt); } else {
#pragma unroll
            for (int h = 0; h < 2; ++h)
#pragma unroll
                for (int i = 0; i < 2; ++i) nvoffA[h][i] = voffA[h][i]; } }
#pragma nounroll
        for (int t = 0; t < nt; t += 2) {
            const bool last = (t == nt - 2);
            const char* a1 = cA + (size_t)(t + 1) * kstep;
            const char* a2 = last ? nA : cA + (size_t)(t + 2) * kstep; const char* b2 = last ? nB : cB + (size_t)(t + 2) * kstep;
            const char* a3 = a2 + kstep; const char* b3 = b2 + kstep;
            unsigned v2[2][2];
#pragma unroll
            for (int h = 0; h < 2; ++h)
#pragma unroll
                for (int i = 0; i < 2; ++i) { if constexpr (GATHER) v2[h][i] = last ? nvoffA[h][i] : voffA[h][i]; else v2[h][i] = voffA[h][i]; }
            PG8_LDB(B0, 0, 0); PG8_LDB(B1, 0, 1); PG8_SCHED; PG8_LDA(At, 0, 0); PG8_STAGE(PG8_SA(1, 1), a1, voffA[1]);
            PG8_WAIT_V(8); PG8_WAIT_L(0); PG8_BAR; PG8_MMA(0, 0, At, B0); PG8_MMA(0, 1, At, B1); PG8_BAR; PG8_SCHED;
            PG8_LDA(At, 0, 1); PG8_STAGE(PG8_SB(0, 0), b2, voffB); PG8_STAGE(PG8_SB(0, 1), b2 + hstepB, voffB); PG8_STAGE(PG8_SA(0, 0), a2, v2[0]);
            PG8_WAIT_V(8); PG8_WAIT_L(0); PG8_BAR; PG8_MMA(1, 0, At, B0); PG8_MMA(1, 1, At, B1); PG8_BAR; PG8_SCHED;
            PG8_LDB(B0, 1, 0); PG8_LDB(B1, 1, 1); PG8_SCHED; PG8_LDA(At, 1, 0); PG8_STAGE(PG8_SA(0, 1), a2, v2[1]);
            PG8_WAIT_V(8); PG8_WAIT_L(0); PG8_BAR; PG8_MMA(0, 0, At, B0); PG8_MMA(0, 1, At, B1); PG8_BAR; PG8_SCHED;
            PG8_LDA(At, 1, 1); PG8_STAGE(PG8_SB(1, 0), b3, voffB); PG8_STAGE(PG8_SB(1, 1), b3 + hstepB, voffB); PG8_STAGE(PG8_SA(1, 0), a3, v2[0]);
            PG8_WAIT_V(8); PG8_WAIT_L(0); PG8_BAR; PG8_MMA(1, 0, At, B0); PG8_MMA(1, 1, At, B1); PG8_BAR; PG8_SCHED;
        }
        if constexpr (ALIGN_EPI) { if (wr == 0) PG8_BAR; }
        { int fr2 = fr, fq2 = fq; asm volatile("" : "+v"(fr2), "+v"(fq2));
          E(acc, cur, wr, wc, fr2, fq2); }
        if (!has_next) break;
#pragma unroll
        for (int a = 0; a < 2; ++a)
#pragma unroll
            for (int b = 0; b < 2; ++b)
#pragma unroll
                for (int m = 0; m < 4; ++m)
#pragma unroll
                    for (int n = 0; n < 2; ++n) acc[a][b][m][n] = (f32x4){0.f, 0.f, 0.f, 0.f};
        cur = nxt; cA = nA; cB = nB; ++ui;
        if constexpr (GATHER) {
#pragma unroll
            for (int h = 0; h < 2; ++h)
#pragma unroll
                for (int i = 0; i < 2; ++i) voffA[h][i] = nvoffA[h][i]; }
        if constexpr (ALIGN_EPI) { if (wr == 1) PG8_BAR; }
    }
    PG8_WAIT_V(0);
    if constexpr (!ALIGN_EPI) { if (wr == 0) PG8_BAR; }
    PG8_BAR;
#undef PG8_SA
#undef PG8_SB
#undef PG8_STAGE
#undef PG8_LDA
#undef PG8_LDB
#undef PG8_MMA
#undef PG8_WAIT_V
#undef PG8_WAIT_L
#undef PG8_BAR
#undef PG8_SCHED
#undef PG8_SETVA
}
}
#define XB_TMO      128
#define XB_XCNT(j)  (256  + 64 * (j))
#define XB_XSUB(j)  (1280 + 64 * (j))
#define XB_XGEN(j)  (2304 + 64 * (j))
#define XB_TOP      3328
#define XB_TOPGEN   3392
#define XCD_BAR_WORDS 3456
#define XB_SPIN_CAP (1u << 18)

__device__ __forceinline__ unsigned xb_ld(unsigned* p)              { return __hip_atomic_load(p, __ATOMIC_RELAXED, __HIP_MEMORY_SCOPE_AGENT); }
__device__ __forceinline__ unsigned xb_add(unsigned* p, unsigned v) { return __hip_atomic_fetch_add(p, v, __ATOMIC_RELAXED, __HIP_MEMORY_SCOPE_AGENT); }
__device__ __forceinline__ unsigned xb_xcc_id() { return (unsigned)__builtin_amdgcn_s_getreg((3 << 11) | 20) & 0xFu; }
#define XB_SPIN(cond, bar) do { unsigned _sp = 0; while (cond) { __builtin_amdgcn_s_sleep(1); \
    if ((++_sp & 255u) == 0u) { if (xb_ld(&(bar)[XB_TMO])) break; if (_sp > XB_SPIN_CAP) { atomicAdd(&(bar)[XB_TMO], 1u); break; } } } } while (0)

struct XcdBarrier {
    unsigned* bar; unsigned x;
    volatile LAS unsigned* st;
};

__device__ __forceinline__ XcdBarrier xcd_barrier_post(unsigned* bar, volatile LAS unsigned* st) {
    XcdBarrier b; b.bar = bar; b.x = xb_xcc_id(); b.st = st;
    if (threadIdx.x == 0) (void)xb_add(&bar[XB_XCNT(b.x)], 1u);
    return b;
}
__device__ __forceinline__ void xcd_barrier_complete(unsigned* bar, unsigned x, unsigned& nloc, unsigned& nx) {
    const unsigned G = gridDim.x * gridDim.y * gridDim.z;
    unsigned sum, cnt, mine, sp = 0u;
    for (;;) {
        sum = 0u; cnt = 0u; mine = 0u;
#pragma unroll
        for (unsigned j = 0; j < 16; ++j) { const unsigned c = xb_ld(&bar[XB_XCNT(j)]); sum += c; cnt += (c > 0u) ? 1u : 0u; mine = (j == x) ? c : mine; }
        if (sum == G) break;
        __builtin_amdgcn_s_sleep(1);
        if ((++sp & 255u) == 0u) { if (xb_ld(&bar[XB_TMO])) break; if (sp > XB_SPIN_CAP) { atomicAdd(&bar[XB_TMO], 1u); break; } }
    }
    nloc = mine > 0u ? mine : 1u; nx = cnt > 0u ? cnt : 1u;
}

__device__ __forceinline__ void xcd_barrier(const XcdBarrier& b) {
    asm volatile("s_waitcnt vmcnt(0)" ::: "memory");
    __syncthreads();
    if (threadIdx.x == 0) {
        unsigned* bar = b.bar;
        __builtin_amdgcn_s_waitcnt(0);
        unsigned nloc = b.st[0], nx = b.st[1];
        if (nloc == 0u) { xcd_barrier_complete(bar, b.x, nloc, nx); b.st[0] = nloc; b.st[1] = nx; }
        const unsigned old = xb_add(&bar[XB_XSUB(b.x)], 1u);
        const unsigned gen = old / nloc;
        if (old + 1u == (gen + 1u) * nloc) {
            __builtin_amdgcn_fence(__ATOMIC_RELEASE, "agent");
            asm volatile("s_waitcnt vmcnt(0)" ::: "memory");
            const unsigned og = xb_add(&bar[XB_TOP], 1u);
            const unsigned tg = og / nx;
            if (og + 1u == (tg + 1u) * nx) xb_add(&bar[XB_TOPGEN], 1u);
            else XB_SPIN(xb_ld(&bar[XB_TOPGEN]) == tg, bar);
            __builtin_amdgcn_fence(__ATOMIC_ACQUIRE, "agent");
            xb_add(&bar[XB_XGEN(b.x)], 1u);
            asm volatile("s_waitcnt vmcnt(0)" ::: "memory");
        } else {
            XB_SPIN(xb_ld(&bar[XB_XGEN(b.x)]) == gen, bar);
            __builtin_amdgcn_fence(__ATOMIC_ACQUIRE, "agent");
            asm volatile("s_waitcnt vmcnt(0)" ::: "memory");
        }
    }
    __syncthreads();
}
constexpr int NWAVES = 8;
constexpr int RING_OFF = 0, RING_BYTES = 131072;
constexpr int LDSCTL_OFF = RING_BYTES, MISC_OFF = LDSCTL_OFF + 320;
constexpr int LDS_BYTES = 147456;
constexpr int CW_TMO = 0, CW_CODE = 1, CW_CNT = 2048, CW_BAR = 4096;
constexpr int N_BAR_REGIONS = 8;
static_assert((CW_BAR + N_BAR_REGIONS * XCD_BAR_WORDS) * 4 <= (int)(1 * MiB), "CTL words inside the memset region");

struct Args { const float* in[32]; float* out; unsigned char* ws; int ph_lo, ph_hi, li, pad; };

__host__ __device__ __forceinline__ int inproj_phys(int L) {
    if (L >= 768) return L; const int o = L & 255, d = o & 63; return (L - o) + 128 * (d >> 5) + 32 * (o >> 6) + (d & 31); }

__device__ __forceinline__ void p0_transpose_item(const float* W, int K, int N, const float* gain, bf16* WT, int ldt, int row_off, int mode, LAS float* scr, int item, int lane) {
    const int nblk = N / 32, kb = item / nblk, nb = item % nblk, k0 = 64 * kb, n0 = 32 * nb;
#pragma unroll 8
    for (int i = 0; i < 32; ++i) { const int kk = 2 * i + (lane >> 5); float v = W[(size_t)(k0 + kk) * N + n0 + (lane & 31)]; if (gain) v *= gain[k0 + kk]; scr[kk * 33 + (lane & 31)] = v; }
    LDS_WAIT(); asm volatile("" ::: "memory");
    const int c = lane & 7;
#pragma unroll
    for (int j = 0; j < 4; ++j) { const int n = (lane >> 3) + 8 * j; const LAS float* s = scr + (8 * c) * 33 + n;
        v4u o; o.x = pk2(s[0 * 33], s[1 * 33]); o.y = pk2(s[2 * 33], s[3 * 33]); o.z = pk2(s[4 * 33], s[5 * 33]); o.w = pk2(s[6 * 33], s[7 * 33]);
        const int nn = n0 + n; const int row = mode == 1 ? inproj_phys(nn) : (mode == 2 ? ((nn >> 7) << 8) + (nn & 127) + row_off : row_off + nn);
        *(GAS v4u*)(WT + (size_t)row * ldt + k0 + 8 * c) = o; }
    LDS_WAIT(); asm volatile("" ::: "memory");
}
struct TrJob { const float* W; const float* gain; bf16* WT; int K, N, ldt, row_off, mode, nmat, rows_per_mat; };
constexpr int N_TRJOBS = 13;
__device__ __forceinline__ TrJob p0_job(const Args& a, int j) {
    unsigned char* ws = a.ws; TrJob t{};
    switch (j) {
    case 0:  t = TrJob{a.in[3],  a.in[2],  (bf16*)(ws + WS_WIN),  D_MODEL, IN_W,    D_MODEL, 0,   1, 1,     0}; break;
    case 1:  t = TrJob{a.in[6],  nullptr,  (bf16*)(ws + WS_WAU),  Q_W,     D_MODEL, Q_W,     0,   0, 1,     0}; break;
    case 2:  t = TrJob{a.in[17], nullptr,  (bf16*)(ws + WS_WSU),  SSM_W,   D_MODEL, SSM_W,   0,   0, 1,     0}; break;
    case 3:  t = TrJob{a.in[15], nullptr,  (bf16*)(ws + WS_WGLU), SSM_W,   SSM_W,   SSM_W,   0,   0, 1,     0}; break;
    case 4:  t = TrJob{a.in[18], nullptr,  (bf16*)(ws + WS_WOUT), D_MODEL, D_MODEL, D_MODEL, 0,   0, 1,     0}; break;
    case 5:  t = TrJob{a.in[22], a.in[19], (bf16*)(ws + WS_WEGU), D_MODEL, EXP_D,   D_MODEL, 0,   0, N_EXP, 256}; break;
    case 6:  t = TrJob{a.in[23], a.in[19], (bf16*)(ws + WS_WEGU), D_MODEL, EXP_D,   D_MODEL, 128, 0, N_EXP, 256}; break;
    case 7:  t = TrJob{a.in[24], nullptr,  (bf16*)(ws + WS_WED),  EXP_D,   D_MODEL, EXP_D,   0,   0, N_EXP, D_MODEL}; break;
    case 8:  t = TrJob{a.in[25], a.in[19], (bf16*)(ws + WS_WSGU), D_MODEL, SH_D,    D_MODEL, 0,   2, 1,     0}; break;
    case 9:  t = TrJob{a.in[26], a.in[19], (bf16*)(ws + WS_WSGU), D_MODEL, SH_D,    D_MODEL, 128, 2, 1,     0}; break;
    case 10: t = TrJob{a.in[27], nullptr,  (bf16*)(ws + WS_WSD),  SH_D,    D_MODEL, SH_D,    0,   0, 1,     0}; break;
    case 11: t = TrJob{a.in[29], a.in[28], (bf16*)(ws + WS_WPG),  D_MODEL, D_MODEL, D_MODEL, 0,   0, 1,     0}; break;
    default: t = TrJob{a.in[30], nullptr,  (bf16*)(ws + WS_WPP),  PLE_D,   D_MODEL, PLE_D,   0,   0, 1,     0}; break;
    }
    return t;
}
__device__ __forceinline__ void row_to_bf16_rstd(const float* xrow, bf16* orow, float* rstd_out, int lane) {
    const GAS f32x4* xr = (const GAS f32x4*)xrow + lane;
    f32x4 v[4]; float s = 0.f;
#pragma unroll
    for (int j = 0; j < 4; ++j) { v[j] = xr[64 * j]; s += (v[j].x * v[j].x + v[j].y * v[j].y) + (v[j].z * v[j].z + v[j].w * v[j].w); }
    s = wave_sum(s);
    if (lane == 0) *rstd_out = rsqrtf(s * (1.f / D_MODEL) + EPS);
    GAS v2u* o8 = (GAS v2u*)orow + lane;
#pragma unroll
    for (int j = 0; j < 4; ++j) o8[64 * j] = (v2u){pk2(v[j].x, v[j].y), pk2(v[j].z, v[j].w)};
}

__device__ __forceinline__ void row_norm_bf16(const float* xrow, bf16* orow, int lane) {
    const GAS f32x4* xr = (const GAS f32x4*)xrow + lane;
    f32x4 v[4]; float s = 0.f;
#pragma unroll
    for (int j = 0; j < 4; ++j) { v[j] = xr[64 * j]; s += (v[j].x * v[j].x + v[j].y * v[j].y) + (v[j].z * v[j].z + v[j].w * v[j].w); }
    const float rs = rsqrtf(wave_sum(s) * (1.f / D_MODEL) + EPS);
    GAS v2u* o8 = (GAS v2u*)orow + lane;
#pragma unroll
    for (int j = 0; j < 4; ++j) o8[64 * j] = (v2u){cvt_pk_bf16(v[j].x * rs, v[j].y * rs), cvt_pk_bf16(v[j].z * rs, v[j].w * rs)};
}
struct EpiInProj {
    static constexpr bool PERM = false;
    const float* rstd; const float* rope; const float* qn; const float* kn;
    bf16 *Q, *K, *V, *ucat, *GA, *GS;
    __device__ __forceinline__ void operator()(const f32x4 (&acc)[2][2][4][2], const pg8::Unit& u, int wr, int wc, int fr, int fq) const {
        const int pn = u.pn; const int rbase = u.pm * 256 + wr * 64 + fr;
        if (pn <= 2) {
            const bool isq = pn < 2;
            if (isq || wc < 2) {
                const float* nw = isq ? qn : kn; f32x4 w[2][2];
#pragma unroll
                for (int bj = 0; bj < 2; ++bj)
#pragma unroll
                    for (int n = 0; n < 2; ++n) w[bj][n] = *(const f32x4*)(nw + 32 * bj + 16 * n + 4 * fq);
                const float osc = isq ? C2 : 1.f;
#pragma unroll
                for (int ai = 0; ai < 2; ++ai)
#pragma unroll
                    for (int m = 0; m < 4; ++m) {
                        const int r = rbase + ai * 128 + m * 16; const float rs1 = rstd[r];
                        f32x4 v[2][2]; float ss = 0.f;
#pragma unroll
                        for (int bj = 0; bj < 2; ++bj)
#pragma unroll
                            for (int n = 0; n < 2; ++n) { v[bj][n] = acc[ai][bj][m][n] * rs1; ss += (v[bj][n].x * v[bj][n].x + v[bj][n].y * v[bj][n].y) + (v[bj][n].z * v[bj][n].z + v[bj][n].w * v[bj][n].w); }
                        ss += __shfl_xor(ss, 16); ss += __shfl_xor(ss, 32);
                        const float rs = rsqrtf(ss * (1.f / 64.f) + EPS);
                        const int pos = r & (SEQ - 1);
                        bf16* dst = isq ? (Q + (size_t)r * Q_W + (pn * 4 + wc) * 64) : (K + (size_t)r * KV_W + wc * 64);
#pragma unroll
                        for (int bj = 0; bj < 2; ++bj) {
                            const int coord = bj ? (pos & 63) : (pos >> 6);
                            const f32x4 cs0 = *(const f32x4*)(rope + (coord * 16 + 4 * fq) * 2), cs1 = *(const f32x4*)(rope + (coord * 16 + 4 * fq) * 2 + 4);
                            const f32x4 cc = (f32x4){cs0.x, cs0.z, cs1.x, cs1.z}, sn = (f32x4){cs0.y, cs0.w, cs1.y, cs1.w};
                            const f32x4 x1 = v[bj][0] * rs * w[bj][0], x2 = v[bj][1] * rs * w[bj][1];
                            const f32x4 o1 = (x1 * cc - x2 * sn) * osc, o2 = (x2 * cc + x1 * sn) * osc;
                            *(v2u*)(dst + 32 * bj + 4 * fq) = (v2u){cvt_pk_bf16(o1.x, o1.y), cvt_pk_bf16(o1.z, o1.w)};
                            *(v2u*)(dst + 32 * bj + 16 + 4 * fq) = (v2u){cvt_pk_bf16(o2.x, o2.y), cvt_pk_bf16(o2.z, o2.w)};
                        }
                    }
            } else {
#pragma unroll
                for (int ai = 0; ai < 2; ++ai)
#pragma unroll
                    for (int m = 0; m < 4; ++m) {
                        const int r = rbase + ai * 128 + m * 16; const float rs1 = rstd[r];
                        bf16* dst = V + (size_t)r * KV_W + (wc - 2) * 64 + 4 * fq;
#pragma unroll
                        for (int bj = 0; bj < 2; ++bj)
#pragma unroll
                            for (int n = 0; n < 2; ++n) { const f32x4 v = acc[ai][bj][m][n] * rs1; *(v2u*)(dst + 32 * bj + 16 * n) = (v2u){cvt_pk_bf16(v.x, v.y), cvt_pk_bf16(v.z, v.w)}; }
                    }
            }
        } else if (pn == 3) {
#pragma unroll
            for (int ai = 0; ai < 2; ++ai)
#pragma unroll
                for (int m = 0; m < 4; ++m) {
                    const int r = rbase + ai * 128 + m * 16; const float rs1 = rstd[r];
                    bf16* dst = ucat + (size_t)(r >> 6) * UCAT_LD + (r & 63) * SSM_G + 4 * fq;
#pragma unroll
                    for (int bj = 0; bj < 2; ++bj)
#pragma unroll
                        for (int n = 0; n < 2; ++n) { const f32x4 v = acc[ai][bj][m][n] * rs1; const int g = 8 * bj + 2 * wc + n;
                            *(v2u*)(dst + (size_t)g * (BATCH * NCHUNK) * UCAT_LD) = (v2u){cvt_pk_bf16(v.x, v.y), cvt_pk_bf16(v.z, v.w)}; }
                }
        } else {
            bf16* G = (pn < 8) ? GA : GS; const int cb = ((pn - 4) & 3) * 256 + wc * 32 + 4 * fq;
#pragma unroll
            for (int ai = 0; ai < 2; ++ai)
#pragma unroll
                for (int m = 0; m < 4; ++m) {
                    const int r = rbase + ai * 128 + m * 16; const float rs1 = rstd[r];
                    bf16* dst = G + (size_t)r * D_MODEL + cb;
#pragma unroll
                    for (int bj = 0; bj < 2; ++bj)
#pragma unroll
                        for (int n = 0; n < 2; ++n) { const f32x4 v = acc[ai][bj][m][n] * rs1;
                            *(v2u*)(dst + 128 * bj + 16 * n) = (v2u){cvt_pk_bf16(fsig(v.x), fsig(v.y)), cvt_pk_bf16(fsig(v.z), fsig(v.w))}; }
                }
        }
    }
};
#include <hip/hip_bf16.h>
namespace attn_body {
using bf16=__hip_bfloat16;
using bf16x8=__attribute__((ext_vector_type(8)))short;
using s16x4=__attribute__((ext_vector_type(4)))short;
using f32x16=__attribute__((ext_vector_type(16)))float;
using u32x4=__attribute__((ext_vector_type(4)))unsigned;
constexpr int BATCH=32,NHEAD=8,NKV=2,SEQ=2048,D=64,QP=NHEAD*D,KP=NKV*D;
constexpr int NW=8,QBLK=32,QB=QBLK*NW,KVBLK=64,NQB=SEQ/QB;
constexpr int ATTN_UNIT_ROWS=QB;
__device__ __forceinline__ int crow(int r,int hi){return (r&3)+8*(r>>2)+4*hi;}
#define SBAR() __builtin_amdgcn_sched_barrier(0)
__device__ __forceinline__ void cmask(f32x16&p0,f32x16&p1,int jb,int qrel,int hi){
  const float NEG=-INFINITY; int kb=64*jb+4*hi;
  #pragma unroll
  for(int r=0;r<16;++r){int kv=kb+(r&3)+8*(r>>2); if(kv>qrel)p0[r]=NEG; if(kv+32>qrel)p1[r]=NEG;}
}

constexpr int NSLOT=3, SLOTB=8192;
constexpr int LDS_K=0, LDS_V=NSLOT*SLOTB, LDS_WS=2*NSLOT*SLOTB, LDS_OST=LDS_WS+NW*64*4, LDS_BYTES=LDS_OST+NW*4096;
constexpr float C2=0.125f*1.4426950408889634f;
__device__ __forceinline__ void glds16(const void*gsrc,unsigned lds_dst){unsigned keep;
  asm volatile("s_mov_b32 %0, m0\n\ts_mov_b32 m0, %2\n\ts_nop 0\n\tglobal_load_lds_dwordx4 %1, off\n\ts_mov_b32 m0, %0":"=&s"(keep):"v"(gsrc),"s"(lds_dst):"memory");}
__device__ __forceinline__ float max3f(float a,float b,float c){float r;asm("v_max3_f32 %0, %1, %2, %3":"=v"(r):"v"(a),"v"(b),"v"(c));return r;}
__device__ __forceinline__ float max2f(float a,float b){float r;asm("v_max_f32_e32 %0, %1, %2":"=v"(r):"v"(a),"v"(b));return r;}
__device__ __forceinline__ float fadd_s(float a,float b){float r;asm("v_add_f32_e32 %0, %1, %2":"=v"(r):"v"(a),"v"(b));return r;}
__device__ __forceinline__ float fsub_s(float a,float b){float r;asm("v_sub_f32_e32 %0, %1, %2":"=v"(r):"v"(a),"v"(b));return r;}
typedef float f32x2_t __attribute__((ext_vector_type(2))); typedef __bf16 bf16x2_t __attribute__((ext_vector_type(2)));
__device__ __forceinline__ unsigned cvtpk_s(float lo,float hi){f32x2_t v={lo,hi};bf16x2_t b=__builtin_convertvector(v,bf16x2_t);return __builtin_bit_cast(unsigned,b);}
#define WAIT_BAR(N) asm volatile("s_waitcnt vmcnt(" #N ") lgkmcnt(0)\n\ts_barrier":::"memory")

__device__ __forceinline__ void qkt(f32x16&p0,f32x16&p1,const char*Kslot,const bf16x8*qr,const f32x16&negm,int r32,int hi){
  const char*kb=Kslot+hi*1024+r32*16;
  #pragma unroll
  for(int d0=0;d0<4;++d0){
    const bf16x8 b0=*reinterpret_cast<const bf16x8*>(kb+d0*2048);
    const bf16x8 b1=*reinterpret_cast<const bf16x8*>(kb+d0*2048+512);
    if(d0==0){p0=__builtin_amdgcn_mfma_f32_32x32x16_bf16(b0,qr[0],negm,0,0,0);p1=__builtin_amdgcn_mfma_f32_32x32x16_bf16(b1,qr[0],negm,0,0,0);}
    else{p0=__builtin_amdgcn_mfma_f32_32x32x16_bf16(b0,qr[d0],p0,0,0,0);p1=__builtin_amdgcn_mfma_f32_32x32x16_bf16(b1,qr[d0],p1,0,0,0);}}
}
typedef __attribute__((address_space(3))) const char* lds_cptr;
typedef short v4i16_t __attribute__((ext_vector_type(4)));
__device__ __forceinline__ void kload8(bf16x8*kf,lds_cptr kp){
  kf[0]=*(const __attribute__((address_space(3))) bf16x8*)(kp);      kf[1]=*(const __attribute__((address_space(3))) bf16x8*)(kp+512);
  kf[2]=*(const __attribute__((address_space(3))) bf16x8*)(kp+2048); kf[3]=*(const __attribute__((address_space(3))) bf16x8*)(kp+2560);
  kf[4]=*(const __attribute__((address_space(3))) bf16x8*)(kp+4096); kf[5]=*(const __attribute__((address_space(3))) bf16x8*)(kp+4608);
  kf[6]=*(const __attribute__((address_space(3))) bf16x8*)(kp+6144); kf[7]=*(const __attribute__((address_space(3))) bf16x8*)(kp+6656);
}
__device__ __forceinline__ void kload2(bf16x8*kf,lds_cptr kp,int j){ kf[2*j]=*(const __attribute__((address_space(3))) bf16x8*)(kp+j*2048); kf[2*j+1]=*(const __attribute__((address_space(3))) bf16x8*)(kp+j*2048+512); }
__device__ __forceinline__ s16x4 vtr(lds_cptr p){ return __builtin_bit_cast(s16x4,__builtin_amdgcn_ds_read_tr16_b64_v4i16((__attribute__((address_space(3))) v4i16_t*)p)); }
__device__ __forceinline__ float rowmax(const f32x16&p0,const f32x16&p1){
  float a=max3f(p0[0],p0[1],p1[0]),b=max3f(p0[2],p0[3],p1[1]);a=max3f(a,p1[2],p1[3]);
  #pragma unroll
  for(int r=4;r<16;r+=4){a=max3f(a,p0[r],p0[r+1]);b=max3f(b,p0[r+2],p0[r+3]);a=max3f(a,p1[r],p1[r+1]);b=max3f(b,p1[r+2],p1[r+3]);}
  const float m=max2f(a,b);
  auto rr=__builtin_amdgcn_permlane32_swap(__float_as_uint(m),__float_as_uint(m),false,false);
  return max2f(__uint_as_float(rr[0]),__uint_as_float(rr[1]));
}
__device__ __forceinline__ void pv(f32x16*o,int vb,bf16x8 pa0,bf16x8 pa1,bf16x8 pa2,bf16x8 pa3){
  #pragma unroll
  for(int d0=0;d0<2;++d0){s16x4 lo[4],hi[4];
    #pragma unroll
    for(int ks=0;ks<4;++ks){
      asm volatile("ds_read_b64_tr_b16 %0,%1 offset:%c2":"=&v"(lo[ks]):"v"(vb),"i"(d0*4096+ks*1024):"memory");
      asm volatile("ds_read_b64_tr_b16 %0,%1 offset:%c2":"=&v"(hi[ks]):"v"(vb),"i"(d0*4096+ks*1024+512):"memory");}
    asm volatile("s_waitcnt lgkmcnt(0)":::"memory");SBAR();
    #define PK(k) (bf16x8){lo[k][0],lo[k][1],lo[k][2],lo[k][3],hi[k][0],hi[k][1],hi[k][2],hi[k][3]}
    o[d0]=__builtin_amdgcn_mfma_f32_32x32x16_bf16(pa0,PK(0),o[d0],0,0,0);
    o[d0]=__builtin_amdgcn_mfma_f32_32x32x16_bf16(pa1,PK(1),o[d0],0,0,0);
    o[d0]=__builtin_amdgcn_mfma_f32_32x32x16_bf16(pa2,PK(2),o[d0],0,0,0);
    o[d0]=__builtin_amdgcn_mfma_f32_32x32x16_bf16(pa3,PK(3),o[d0],0,0,0);
    #undef PK
  }
}

#ifndef ATTN_STORE16
#define ATTN_STORE16(p,v) (*(u32x4*)(p)=(v))
#endif
template<int THRL> __device__ __forceinline__ void attn_unit(int b,int h,int qb,const bf16*Q,const bf16*__restrict__ K,const bf16*__restrict__ V,bf16*O,char*shm){
  int tid=threadIdx.x; asm volatile("":"+v"(tid)); const int lane=tid&63,r32=lane&31,hi=lane>>5; const int wid=__builtin_amdgcn_readfirstlane(tid>>6);
  const long rowbase=(long)b*SEQ; const int q0=qb*QB; const int kvh=h/(NHEAD/NKV);
  const bf16*Qw=Q+(rowbase+q0+wid*QBLK)*QP+h*D;
  const bf16*Kh=K+rowbase*KP+kvh*D,*Vh=V+rowbase*KP+kvh*D;
  const unsigned lds0=(unsigned)(uintptr_t)shm;
  float*wsf=(float*)(shm+LDS_WS)+wid*64;
  const bf16*ksrc=Kh+(long)lane*KP+wid*8;
  const bf16*vsrc=Vh+(long)(16*(wid&3)+(lane>>2))*KP+(wid>>2)*32+(lane&3)*8;
  const unsigned kdst=lds0+LDS_K+wid*1024, vdst=lds0+LDS_V+wid*1024;
  #define DMA_K(t,slot) glds16(ksrc+(long)(t)*KVBLK*KP,(unsigned)__builtin_amdgcn_readfirstlane(kdst+(slot)))
  #define DMA_V(t,slot) glds16(vsrc+(long)(t)*KVBLK*KP,(unsigned)__builtin_amdgcn_readfirstlane(vdst+(slot)))
  const int vb0=(int)(lds0+LDS_V)+((lane>>4)&1)*32+(lane&3)*8+(4*hi+((lane&15)>>2))*64;
  const char*Kbase=shm+LDS_K; bf16x8 kf[8];
  const lds_cptr shm3=(lds_cptr)shm; const lds_cptr kp0=shm3+LDS_K+hi*1024+r32*16; const lds_cptr vp0=shm3+LDS_V+((lane>>4)&1)*32+(lane&3)*8+(4*hi+((lane&15)>>2))*64;
  constexpr int NT=SEQ/KVBLK;
  DMA_K(0,0);DMA_V(0,0);DMA_K(1,SLOTB);
  bf16x8 qr[4];
  #pragma unroll
  for(int d0=0;d0<4;++d0)qr[d0]=*reinterpret_cast<const bf16x8*>(&Qw[(long)r32*QP+d0*16+hi*8]);
  float mhat=0.f,l_reg=0.f;f32x16 o[2];o[0]=f32x16{};o[1]=f32x16{};f32x16 negm=f32x16{};asm volatile("":"+v"(negm));
  #define CMASK(P0,P1,t) do{}while(0)
  bool resc=false;
  #define START(P0,P1) do{ const float rm=rowmax(P0,P1); resc=false; \
    { const float dl=rm; mhat=fadd_s(mhat,dl); \
      _Pragma("unroll") for(int r=0;r<16;++r){P0[r]=fsub_s(P0[r],dl);P1[r]=fsub_s(P1[r],dl);} \
      _Pragma("unroll") for(int r=0;r<16;++r)negm[r]=-mhat; asm volatile("":"+v"(negm)); } \
    _Pragma("unroll") for(int r=0;r<16;++r)P0[r]=__builtin_amdgcn_exp2f(P0[r]); }while(0)
  #define RESC() do{ if(resc){ asm volatile("s_waitcnt lgkmcnt(0)":::"memory"); \
      _Pragma("unroll") for(int d_=0;d_<2;++d_) _Pragma("unroll") for(int r=0;r<16;++r)o[d_][r]*=wsf[crow(r,hi)]; } }while(0)
  f32x16 pA0,pA1,pB0,pB1;
  int sl_prev=0,sl_cur=0,sl_next=SLOTB;
  #define ROT() do{sl_prev=sl_cur;sl_cur=sl_next;sl_next=(sl_next==(NSLOT-1)*SLOTB)?0:sl_next+SLOTB;}while(0)
  DMA_K(2,2*SLOTB);
  WAIT_BAR(3);
  qkt(pA0,pA1,Kbase,qr,negm,r32,hi);asm volatile("s_nop 15\n\ts_nop 7":"+v"(pA0),"+v"(pA1));CMASK(pA0,pA1,0);
  START(pA0,pA1);
  _Pragma("unroll") for(int r=0;r<16;++r)pA1[r]=__builtin_amdgcn_exp2f(pA1[r]);
  WAIT_BAR(0);
  DMA_K(3,0);DMA_V(1,SLOTB);
  ROT();
  kload8(kf,kp0+sl_cur);
  WAIT_BAR(2);
  s16x4 vlo[8],vhi[8]; u32x4 pw0,pw1,pw2,pw3;
  #define PKW(P,B) cvtpk_s(P[B],P[B+1])
  #define PAF(k) __builtin_bit_cast(bf16x8,pw##k)
  #define VFR(i) (bf16x8){vlo[i][0],vlo[i][1],vlo[i][2],vlo[i][3],vhi[i][0],vhi[i][1],vhi[i][2],vhi[i][3]}
  #define PIN(x) asm volatile("":"+v"(x))
  #define MX3(a,b,c) __builtin_fmaxf(__builtin_fmaxf((a),(b)),(c))
  #define GAPA(MF,A0,A1,A2,A3,W0,W1,PW) do{ MF; sacc+=A0; sacc+=A1; sacc+=A2; sacc+=A3; PIN(sacc); W0; W1; PIN(PW); SBAR(); }while(0)
  #define EX(v) __builtin_amdgcn_exp2f(v)
  #define GAPB(MF,X,B) do{ MF; X[B]=EX(X[B]); X[B+1]=EX(X[B+1]); X[B+2]=EX(X[B+2]); X[B+3]=EX(X[B+3]); PIN(X); SBAR(); }while(0)
  #define VRD(i) do{ vlo[i]=vtr(vp_+(((i)>>2)*4096+((i)&3)*1024)); vhi[i]=vtr(vp_+(((i)>>2)*4096+((i)&3)*1024+512)); }while(0)
  #define KRD(G,j) do{ if(G){ kload2(kf,kp0+sl_next,j); SBAR(); } }while(0)
  #define STEP(C0,C1,P0,P1,t,GK,GV,GL) do{ SBAR(); \
    const lds_cptr vp_=vp0+sl_prev; \
    VRD(0); SBAR(); float sacc=(P0[0]+P0[1]); \
    GAPA(C0=__builtin_amdgcn_mfma_f32_32x32x16_bf16(kf[0],qr[0],negm,0,0,0), P0[2],P0[3],P0[4],P0[5],     pw0[0]=PKW(P0,0), pw0[1]=PKW(P0,2), pw0); \
    VRD(4); SBAR(); GAPA(C1=__builtin_amdgcn_mfma_f32_32x32x16_bf16(kf[1],qr[0],negm,0,0,0), P0[6],P0[7],P0[8],P0[9],     pw0[2]=PKW(P0,4), pw0[3]=PKW(P0,6), pw0); \
    VRD(1); SBAR(); GAPA(C0=__builtin_amdgcn_mfma_f32_32x32x16_bf16(kf[2],qr[1],C0,0,0,0),   P0[10],P0[11],P0[12],P0[13], pw1[0]=PKW(P0,8), pw1[1]=PKW(P0,10), pw1); \
    VRD(5); SBAR(); GAPA(C1=__builtin_amdgcn_mfma_f32_32x32x16_bf16(kf[3],qr[1],C1,0,0,0),   P0[14],P0[15],P1[0],P1[1],   pw1[2]=PKW(P0,12),pw1[3]=PKW(P0,14), pw1); \
    VRD(2); SBAR(); GAPA(C0=__builtin_amdgcn_mfma_f32_32x32x16_bf16(kf[4],qr[2],C0,0,0,0),   P1[2],P1[3],P1[4],P1[5],     pw2[0]=PKW(P1,0), pw2[1]=PKW(P1,2), pw2); \
    VRD(6); SBAR(); GAPA(C1=__builtin_amdgcn_mfma_f32_32x32x16_bf16(kf[5],qr[2],C1,0,0,0),   P1[6],P1[7],P1[8],P1[9],     pw2[2]=PKW(P1,4), pw2[3]=PKW(P1,6), pw2); \
    VRD(3); SBAR(); GAPA(C0=__builtin_amdgcn_mfma_f32_32x32x16_bf16(kf[6],qr[3],C0,0,0,0),   P1[10],P1[11],P1[12],P1[13], pw3[0]=PKW(P1,8), pw3[1]=PKW(P1,10), pw3); \
    VRD(7); SBAR(); GAPA(C1=__builtin_amdgcn_mfma_f32_32x32x16_bf16(kf[7],qr[3],C1,0,0,0),   P1[14],P1[15],0.f,0.f,       pw3[2]=PKW(P1,12),pw3[3]=PKW(P1,14), pw3); \
    l_reg+=sacc; \
    if(GK){DMA_K((t)+3,sl_cur);} if(GV){DMA_V((t)+1,sl_next);} \
    CMASK(C0,C1,t); \
    { float a=MX3(C0[0],C0[1],C1[0]),b=MX3(C0[2],C0[3],C1[1]); a=MX3(a,C1[2],C1[3]); \
      _Pragma("unroll") for(int r=4;r<16;r+=4){a=MX3(a,C0[r],C0[r+1]);b=MX3(b,C0[r+2],C0[r+3]);a=MX3(a,C1[r],C1[r+1]);b=MX3(b,C1[r+2],C1[r+3]);} \
      float rm=__builtin_fmaxf(a,b); { auto rr=__builtin_amdgcn_permlane32_swap(__float_as_uint(rm),__float_as_uint(rm),false,false); rm=__builtin_fmaxf(__uint_as_float(rr[0]),__uint_as_float(rr[1])); } \
      resc=false; \
      if(__builtin_expect(__any(rm>(float)THRL),0)){ const float dl=__builtin_fmaxf(rm,0.f); mhat+=dl; \
        _Pragma("unroll") for(int r=0;r<16;++r){C0[r]-=dl;C1[r]-=dl;} \
        _Pragma("unroll") for(int r=0;r<16;++r)negm[r]=-mhat; asm volatile("":"+v"(negm)); \
        const float f=__builtin_amdgcn_exp2f(-dl); l_reg*=f; if(hi==0)wsf[r32]=f; resc=true; } } \
    SBAR(); \
    GAPB(o[0]=__builtin_amdgcn_mfma_f32_32x32x16_bf16(PAF(0),VFR(0),o[0],0,0,0), C0,0); \
    GAPB(o[1]=__builtin_amdgcn_mfma_f32_32x32x16_bf16(PAF(0),VFR(4),o[1],0,0,0), C0,4); \
    KRD(GL,0); GAPB(o[0]=__builtin_amdgcn_mfma_f32_32x32x16_bf16(PAF(1),VFR(1),o[0],0,0,0), C0,8); \
    KRD(GL,1); GAPB(o[1]=__builtin_amdgcn_mfma_f32_32x32x16_bf16(PAF(1),VFR(5),o[1],0,0,0), C0,12); \
    KRD(GL,2); GAPB(o[0]=__builtin_amdgcn_mfma_f32_32x32x16_bf16(PAF(2),VFR(2),o[0],0,0,0), C1,0); \
    KRD(GL,3); GAPB(o[1]=__builtin_amdgcn_mfma_f32_32x32x16_bf16(PAF(2),VFR(6),o[1],0,0,0), C1,4); \
    GAPB(o[0]=__builtin_amdgcn_mfma_f32_32x32x16_bf16(PAF(3),VFR(3),o[0],0,0,0), C1,8); \
    GAPB(o[1]=__builtin_amdgcn_mfma_f32_32x32x16_bf16(PAF(3),VFR(7),o[1],0,0,0), C1,12); \
    }while(0)
  int t=1;
  #undef CMASK
  #define CMASK(P0,P1,t) do{}while(0)
  for(;t+5<NT;t+=2){
    STEP(pB0,pB1,pA0,pA1,t,true,true,true);     WAIT_BAR(2); RESC(); ROT();
    STEP(pA0,pA1,pB0,pB1,t+1,true,true,true);   WAIT_BAR(2); RESC(); ROT();
  }
  #undef CMASK
  #define CMASK(P0,P1,t) do{}while(0)
  #define ENDW(tt) do{ if((tt)+3<NT){WAIT_BAR(2);} else if((tt)+2<NT){WAIT_BAR(1);} else {WAIT_BAR(0);} }while(0)
  for(;t+1<NT;t+=2){
    STEP(pB0,pB1,pA0,pA1,t,(t+3<NT),(t+1<NT),(t+1<NT));       ENDW(t);   RESC(); ROT();
    STEP(pA0,pA1,pB0,pB1,t+1,(t+4<NT),(t+2<NT),(t+2<NT));     ENDW(t+1); RESC(); ROT();
  }
  STEP(pB0,pB1,pA0,pA1,NT-1,false,false,false); RESC();
  { float sacc=pB0[0]+pB0[1]; _Pragma("unroll") for(int r=2;r<16;++r)sacc+=pB0[r]; _Pragma("unroll") for(int r=0;r<16;++r)sacc+=pB1[r]; l_reg+=sacc;
    pw0=(u32x4){PKW(pB0,0),PKW(pB0,2),PKW(pB0,4),PKW(pB0,6)};pw1=(u32x4){PKW(pB0,8),PKW(pB0,10),PKW(pB0,12),PKW(pB0,14)};pw2=(u32x4){PKW(pB1,0),PKW(pB1,2),PKW(pB1,4),PKW(pB1,6)};pw3=(u32x4){PKW(pB1,8),PKW(pB1,10),PKW(pB1,12),PKW(pB1,14)};
    SBAR(); pv(o,vb0+sl_cur,PAF(0),PAF(1),PAF(2),PAF(3)); }
  #undef PKW
  #undef PAF
  #undef VFR
  #undef PIN
  #undef MX3
  #undef GAPA
  #undef GAPB
  #undef EX
  #undef VRD
  #undef KRD
  #undef STEP
  #undef ENDW
  {auto rr=__builtin_amdgcn_permlane32_swap(__float_as_uint(l_reg),__float_as_uint(l_reg),false,false);l_reg=__uint_as_float(rr[0])+__uint_as_float(rr[1]);}
  if(hi==0)wsf[32+r32]=l_reg;asm volatile("s_waitcnt lgkmcnt(0)":::"memory");
  float rli[16];
  #pragma unroll
  for(int r=0;r<16;++r)rli[r]=__builtin_amdgcn_rcpf(wsf[32+crow(r,hi)]);
  bf16*Ow=O+(rowbase+q0+wid*QBLK)*QP+h*D;
  { bf16*stg=(bf16*)(shm+LDS_OST)+wid*2048;
    #pragma unroll
    for(int r=0;r<16;++r){const int orow=crow(r,hi);
      #pragma unroll
      for(int d0=0;d0<2;++d0)stg[orow*64+d0*32+r32]=__float2bfloat16(o[d0][r]*rli[r]);}
    asm volatile("s_waitcnt lgkmcnt(0)":::"memory");
    #pragma unroll
    for(int i=0;i<4;++i){const int row=i*8+(lane>>3),ch=lane&7; const u32x4 v=*(const u32x4*)(stg+row*64+ch*8); ATTN_STORE16(Ow+(long)row*QP+ch*8,v);} }
  asm volatile("s_waitcnt lgkmcnt(0)\n\ts_barrier":::"memory");
  #undef DMA_K
  #undef DMA_V
  #undef CMASK
  #undef START
  #undef RESC
  #undef ROT
}
constexpr int ATTN_LDS_BYTES=LDS_BYTES;
struct AttnTensors { const bf16* Q; const bf16* K; const bf16* V; bf16* O; };
struct AttnUnit { int bh; int qb; };
struct StaticOrder {
  int vcu, grid;
  __device__ __forceinline__ explicit StaticOrder(int grid_,int vcu_):vcu(vcu_),grid(grid_){}
  __device__ __forceinline__ bool next(int i,AttnUnit&u)const{ const int pair=vcu+(i>>3)*grid; if(pair>=BATCH*NHEAD)return false; const int bk=pair>>2; u.bh=(bk>>1)*NHEAD+(bk&1)*(NHEAD/NKV)+(pair&3); u.qb=i&7; return true; }
  __device__ __forceinline__ void a_ready(const AttnUnit&)const{}
  __device__ __forceinline__ void done(const AttnUnit&)const{}
};
template<class Sched,int THRL=8> __device__ __forceinline__ void attn_phase(char*lds,const AttnTensors&T,const Sched&S){
  AttnUnit u;
  for(int i=0;S.next(i,u);++i){ S.a_ready(u); attn_unit<THRL>(u.bh/NHEAD,u.bh%NHEAD,u.qb,T.Q,T.K,T.V,T.O,lds); S.done(u); }
}
#undef SBAR
#undef WAIT_BAR
}
struct SsmLane { float are, aim, dt, cfr, cfi; };
__device__ __forceinline__ void cpow_(const SsmLane& L, float e, float& re, float& im) { const float mag = __expf(e * L.are * L.dt); float sn, cs; sincosf(e * L.aim * L.dt, &sn, &cs); re = mag * cs; im = mag * sn; }
__device__ __forceinline__ SsmLane ssm_lane(const float* a_re, const float* a_im, const float* log_dt, int gi, int p) {
    SsmLane L; L.are = a_re[gi * SSM_P + p]; L.aim = a_im[gi * SSM_P + p]; L.dt = expf(log_dt[gi]);
    float abr, abi; cpow_(L, 1.f, abr, abi);
    const float nr = abr - 1.f, ni = abi, den = L.are * L.are + L.aim * L.aim;
    L.cfr = (nr * L.are + ni * L.aim) / den; L.cfi = (ni * L.are - nr * L.aim) / den; return L;
}
struct SsmIn { const float *a_re, *a_im, *log_dt, *b_re, *b_im, *c_re, *c_im, *d_skip; };
__device__ __forceinline__ void ssm_item_toep(const SsmIn& P, bf16* btcat, LAS float* scr, int item, int lane) {
    const int g = item / 127, tau = item % 127 - 63, at = tau < 0 ? -tau : tau;
    const int c = lane >> 2, c0 = (lane & 3) * 4;
    f32x4 out = (f32x4){0.f, 0.f, 0.f, 0.f};
    for (int dir = 0; dir < 2; ++dir) {
        if ((tau > 0 && dir == 1) || (tau < 0 && dir == 0)) continue;
        const int gi = dir * SSM_NG + g;
        const SsmLane L = ssm_lane(P.a_re, P.a_im, P.log_dt, gi, lane);
        float pr, pi; cpow_(L, (float)at, pr, pi);
        scr[2 * lane] = pr * L.cfr - pi * L.cfi; scr[2 * lane + 1] = pr * L.cfi + pi * L.cfr;
        LDS_WAIT(); asm volatile("" ::: "memory");
        for (int p = 0; p < SSM_P; ++p) {
            const float wr_ = scr[2 * p], wi_ = scr[2 * p + 1];
            const float cr = P.c_re[((size_t)gi * SSM_G + c) * SSM_P + p], ci = P.c_im[((size_t)gi * SSM_G + c) * SSM_P + p];
            const float zr = cr * wr_ - ci * wi_, zi = cr * wi_ + ci * wr_;
            const f32x4 br = *(const f32x4*)(P.b_re + ((size_t)gi * SSM_P + p) * SSM_G + c0), bi = *(const f32x4*)(P.b_im + ((size_t)gi * SSM_P + p) * SSM_G + c0);
            out += br * zr - bi * zi;
        }
        LDS_WAIT(); asm volatile("" ::: "memory");
    }
    if (tau == 0) { const float d = P.d_skip[g * SSM_G + c]; if (c == c0) out.x += d; if (c == c0 + 1) out.y += d; if (c == c0 + 2) out.z += d; if (c == c0 + 3) out.w += d; }
    const v2u pk = (v2u){cvt_pk_bf16(out.x, out.y), cvt_pk_bf16(out.z, out.w)};
    const int n = 64 - at;
    for (int q = 0; q < n; ++q) { const int s = tau >= 0 ? q : q + at, t = tau >= 0 ? q + at : q;
        *(GAS v2u*)(btcat + ((size_t)g * 1024 + t * SSM_G + c) * UCAT_LD + s * SSM_G + c0) = pk; }
}
__device__ __forceinline__ void ssm_item_out(const SsmIn& P, bf16* btcat, int item, int lane) {
    const int g = item >> 6, t = item & 63;
#pragma unroll
    for (int dir = 0; dir < 2; ++dir) {
        const int gi = dir * SSM_NG + g; const SsmLane L = ssm_lane(P.a_re, P.a_im, P.log_dt, gi, lane);
        float pr, pi; cpow_(L, dir ? (float)(64 - t) : (float)(t + 1), pr, pi);
        for (int c = 0; c < SSM_G; ++c) {
            const float cr = P.c_re[((size_t)gi * SSM_G + c) * SSM_P + lane], ci = P.c_im[((size_t)gi * SSM_G + c) * SSM_P + lane];
            *(GAS unsigned*)(btcat + ((size_t)g * 1024 + t * SSM_G + c) * UCAT_LD + 1024 + dir * 128 + 2 * lane) = cvt_pk_bf16(cr * pr - ci * pi, -(cr * pi + ci * pr));
        }
    }
}
__device__ __forceinline__ void ssm_item_state(const SsmIn& P, bf16* btst, int item, int lane) {
    const int g = item >> 6, s = item & 63;
#pragma unroll
    for (int dir = 0; dir < 2; ++dir) {
        const int gi = dir * SSM_NG + g; const SsmLane L = ssm_lane(P.a_re, P.a_im, P.log_dt, gi, lane);
        float pr, pi; cpow_(L, dir ? (float)s : (float)(63 - s), pr, pi);
        const float wr_ = pr * L.cfr - pi * L.cfi, wi_ = pr * L.cfi + pi * L.cfr;
        bf16* rre = btst + ((size_t)g * 256 + dir * 128 + 2 * lane) * 1024 + s * SSM_G; bf16* rim = rre + 1024;
#pragma unroll
        for (int q = 0; q < 4; ++q) {
            const f32x4 br = *(const f32x4*)(P.b_re + ((size_t)gi * SSM_P + lane) * SSM_G + 4 * q), bi = *(const f32x4*)(P.b_im + ((size_t)gi * SSM_P + lane) * SSM_G + 4 * q);
            const f32x4 vr = br * wr_ - bi * wi_, vi = br * wi_ + bi * wr_;
            *(GAS v2u*)(rre + 4 * q) = (v2u){cvt_pk_bf16(vr.x, vr.y), cvt_pk_bf16(vr.z, vr.w)};
            *(GAS v2u*)(rim + 4 * q) = (v2u){cvt_pk_bf16(vi.x, vi.y), cvt_pk_bf16(vi.z, vi.w)};
        }
    }
}
constexpr int SSM_I_TOEP = SSM_NG * 127, SSM_I_OUT = SSM_NG * 64, SSM_I_STATE = SSM_NG * 64, SSM_ITEMS = SSM_I_TOEP + SSM_I_OUT + SSM_I_STATE;

struct StateOrder { const char* ucat; const char* btst; int G, c;
    __device__ __forceinline__ bool next(int i, pg8::Unit& u) const { const int L = i * G + c; if (L >= SSM_NG * 4) return false; const int g = L >> 2; u.pm = L & 3; u.pn = 0; u.aux = g;
        u.A = ucat + ((size_t)g * 1024 + u.pm * 256) * (UCAT_LD * 2); u.B = btst + (size_t)g * 256 * 2048; u.rows = nullptr; u.nrows = 256; return true; } };
struct EpiState { static constexpr bool PERM = false; float* lst;
    __device__ __forceinline__ void operator()(const f32x4 (&acc)[2][2][4][2], const pg8::Unit& u, int wr, int wc, int fr, int fq) const {
#pragma unroll
        for (int ai = 0; ai < 2; ++ai)
#pragma unroll
            for (int m = 0; m < 4; ++m) { float* dst = lst + ((size_t)u.aux * 1024 + u.pm * 256 + ai * 128 + wr * 64 + m * 16 + fr) * 256 + wc * 32 + 4 * fq;
#pragma unroll
                for (int bj = 0; bj < 2; ++bj)
#pragma unroll
                    for (int n = 0; n < 2; ++n) *(f32x4*)(dst + 128 * bj + 16 * n) = acc[ai][bj][m][n]; }
    } };
__device__ __forceinline__ void ssm_carry(const SsmIn& P, const float* lst, bf16* ucat, int idx) {
    const int p = idx & 63, dir = (idx >> 6) & 1, b = (idx >> 7) & 31, g = idx >> 12;
    const SsmLane L = ssm_lane(P.a_re, P.a_im, P.log_dt, dir * SSM_NG + g, p);
    float ar, ai; cpow_(L, 64.f, ar, ai);
    float sr = 0.f, si = 0.f;
    for (int jj = 0; jj < NCHUNK; ++jj) { const int j = dir ? NCHUNK - 1 - jj : jj; const size_t row = (size_t)g * 1024 + b * NCHUNK + j;
        const f32x2 l = *(const f32x2*)(lst + row * 256 + dir * 128 + 2 * p);
        *(GAS unsigned*)(ucat + row * UCAT_LD + 1024 + dir * 128 + 2 * p) = pk2(sr, si);
        const float nr = ar * sr - ai * si + l.x, ni = ar * si + ai * sr + l.y; sr = nr; si = ni; }
}
struct YOrder { const char* ucat; const char* btcat; int G, c;
    __device__ __forceinline__ bool next(int i, pg8::Unit& u) const { const int L = i * G + c; if (L >= SSM_NG * 16) return false; const int g = L >> 4; u.pm = (L >> 2) & 3; u.pn = L & 3; u.aux = g;
        u.A = ucat + ((size_t)g * 1024 + u.pm * 256) * (UCAT_LD * 2); u.B = btcat + ((size_t)g * 1024 + u.pn * 256) * (UCAT_LD * 2); u.rows = nullptr; u.nrows = 256; return true; } };
struct EpiY { static constexpr bool PERM = false; bf16* yact;
    __device__ __forceinline__ void operator()(const f32x4 (&acc)[2][2][4][2], const pg8::Unit& u, int wr, int wc, int fr, int fq) const {
#pragma unroll
        for (int ai = 0; ai < 2; ++ai)
#pragma unroll
            for (int m = 0; m < 4; ++m) { const int chunk = u.pm * 256 + ai * 128 + wr * 64 + m * 16 + fr;
#pragma unroll
                for (int bj = 0; bj < 2; ++bj)
#pragma unroll
                    for (int n = 0; n < 2; ++n) { const int t = 16 * u.pn + 8 * bj + 2 * wc + n; f32x4 v = acc[ai][bj][m][n], o;
#pragma unroll
                        for (int j = 0; j < 4; ++j) { const float x = v[j]; o[j] = x * fsig(1.5957691216057308f * (x + 0.044715f * x * x * x)); }
                        *(v2u*)(yact + ((size_t)chunk * CH_T + t) * SSM_W + u.aux * SSM_G + 4 * fq) = (v2u){cvt_pk_bf16(o.x, o.y), cvt_pk_bf16(o.z, o.w)}; } }
    } };
__device__ __forceinline__ f32x4 unpack4(v2u w) { return (f32x4){__builtin_bit_cast(float, w.x << 16), __builtin_bit_cast(float, w.x & 0xffff0000u), __builtin_bit_cast(float, w.y << 16), __builtin_bit_cast(float, w.y & 0xffff0000u)}; }
__device__ __forceinline__ v2u pack4(f32x4 v) { return (v2u){cvt_pk_bf16(v.x, v.y), cvt_pk_bf16(v.z, v.w)}; }
#define EPI_WALK(u, BODY) do { _Pragma("unroll") for (int ai = 0; ai < 2; ++ai) _Pragma("unroll") for (int m = 0; m < 4; ++m) { const int r = (u).pm * 256 + ai * 128 + wr * 64 + m * 16 + fr; \
    _Pragma("unroll") for (int bj = 0; bj < 2; ++bj) _Pragma("unroll") for (int n = 0; n < 2; ++n) { const int col = (u).pn * 256 + 128 * bj + 32 * wc + 16 * n + 4 * fq; const f32x4 a4 = acc[ai][bj][m][n]; BODY } asm volatile("" ::: "memory"); } } while (0)
struct EpiGlu { static constexpr bool PERM = false; bf16* y; const float* bglu;
    __device__ __forceinline__ void operator()(const f32x4 (&acc)[2][2][4][2], const pg8::Unit& u, int wr, int wc, int fr, int fq) const {
        EPI_WALK(u, { bf16* p = y + (size_t)r * SSM_W + col; const f32x4 yv = unpack4(*(const v2u*)p); const f32x4 z = a4 + *(const f32x4*)(bglu + col);
            *(v2u*)p = pack4((f32x4){yv.x * fsig(z.x), yv.y * fsig(z.y), yv.z * fsig(z.z), yv.w * fsig(z.w)}); }); } };
template <bool FIRST> struct EpiMerge { static constexpr bool PERM = false; bf16* mbuf; const bf16* gate;
    __device__ __forceinline__ void operator()(const f32x4 (&acc)[2][2][4][2], const pg8::Unit& u, int wr, int wc, int fr, int fq) const {
        EPI_WALK(u, { const size_t o = (size_t)r * D_MODEL + col; const f32x4 gv = unpack4(*(const v2u*)(gate + o));
            if (FIRST) *(v2u*)(mbuf + o) = pack4(gv * a4); else { const f32x4 mv = unpack4(*(const v2u*)(mbuf + o)); *(v2u*)(mbuf + o) = pack4(mv + gv * a4); } }); } };
struct EpiResid { static constexpr bool PERM = false; const float* base; float* out;
    __device__ __forceinline__ void operator()(const f32x4 (&acc)[2][2][4][2], const pg8::Unit& u, int wr, int wc, int fr, int fq) const {
        EPI_WALK(u, { const size_t o = (size_t)r * D_MODEL + col; *(f32x4*)(out + o) = *(const f32x4*)(base + o) + a4; }); } };
constexpr int EXP_CAP = NTOK;
constexpr int MAX_RTILES = (NTOK * TOP_K) / 256 + N_EXP;
constexpr int YS_W = 512;
constexpr int LDS_TAB_OFF = LDSCTL_OFF + 1024;
struct MoeBufs { bf16* xn2; float* logit; int* cnt; int* list_tok; float* list_w; int* list_row; const int* ident; bf16* hid; bf16* hsh; bf16* yslot; bf16* ysh; };

struct OneTileOrder { const char* A; const char* B; int G, c, ntiles; unsigned lda2;
    __device__ __forceinline__ bool next(int i, pg8::Unit& u) const { const int L = i * G + c; if (L >= ntiles) return false; u.pm = L; u.pn = 0; u.aux = 0; u.A = A + (size_t)L * 256 * lda2; u.B = B; u.rows = nullptr; u.nrows = 256; return true; } };
struct EpiRouter { static constexpr bool PERM = false; float* logit;
    __device__ __forceinline__ void operator()(const f32x4 (&acc)[2][2][4][2], const pg8::Unit& u, int wr, int wc, int fr, int fq) const {
#pragma unroll
        for (int ai = 0; ai < 2; ++ai)
#pragma unroll
            for (int m = 0; m < 4; ++m) { float* dst = logit + (size_t)(u.pm * 256 + ai * 128 + wr * 64 + m * 16 + fr) * 128 + 32 * wc + 4 * fq;
#pragma unroll
                for (int n = 0; n < 2; ++n) *(f32x4*)(dst + 16 * n) = acc[ai][0][m][n]; }
    } };
__device__ __forceinline__ void route_token(const float* lg, const float* rbias, int (&idx)[8], float (&wgt)[8]) {
    float s[64], bsd[64];
#pragma unroll
    for (int q = 0; q < 16; ++q) { const f32x4 h = *(const f32x4*)(lg + 4 * q), l = *(const f32x4*)(lg + 64 + 4 * q), b = *(const f32x4*)(rbias + 4 * q);
#pragma unroll
        for (int j = 0; j < 4; ++j) { s[4 * q + j] = sigmoidf_(h[j] + l[j]); bsd[4 * q + j] = s[4 * q + j] + b[j]; } }
    float gs[8];
#pragma unroll
    for (int g = 0; g < 8; ++g) { float m1 = -INFINITY, m2 = -INFINITY;
#pragma unroll
        for (int j = 0; j < 8; ++j) { const float v = bsd[g * 8 + j]; if (v > m1) { m2 = m1; m1 = v; } else if (v > m2) m2 = v; }
        gs[g] = m1 + m2; }
    unsigned gmask = 0;
#pragma unroll
    for (int k = 0; k < TOPK_G; ++k) { int best = 0; float bv = -INFINITY;
#pragma unroll
        for (int g = 0; g < 8; ++g) if (!((gmask >> g) & 1u) && gs[g] > bv) { bv = gs[g]; best = g; }
        gmask |= 1u << best; }
    unsigned long long emask = 0ull; float wsum = 0.f;
#pragma unroll
    for (int k = 0; k < TOP_K; ++k) { int best = 0; float bv = -INFINITY, sv = 0.f;
#pragma unroll
        for (int e = 0; e < 64; ++e) { const bool ok = ((gmask >> (e >> 3)) & 1u) && !((emask >> e) & 1ull); if (ok && bsd[e] > bv) { bv = bsd[e]; best = e; sv = s[e]; } }
        emask |= 1ull << best; idx[k] = best; wgt[k] = sv; wsum += sv; }
    const float sc = ROUTED_SCALE / wsum;
#pragma unroll
    for (int k = 0; k < TOP_K; ++k) wgt[k] *= sc;
}
__device__ __forceinline__ void moe_build_tab(LAS int* tab, const int* cnt, int tid) {
    if (tid < 64) tab[128 + tid] = __hip_atomic_load(cnt + tid, __ATOMIC_RELAXED, __HIP_MEMORY_SCOPE_AGENT);
    __syncthreads();
    if (tid == 0) { int s = 0; for (int e = 0; e < 64; ++e) { tab[e] = s; s += (tab[128 + e] + 255) >> 8; } tab[64] = s; }
    __syncthreads();
}
#define RFL(x) __builtin_amdgcn_readfirstlane(x)
__device__ __forceinline__ int moe_find(const LAS int* tab, int tile) { int e = 0;
#pragma unroll
    for (int j = 32; j >= 1; j >>= 1) if (RFL(tab[e + j]) <= tile) e += j;
    return e; }
struct GuOrder { const LAS int* tab; const char* xn2; const char* wegu; const char* wsgu; const int* list_tok; const int* ident; int G, c;
    __device__ __forceinline__ bool next(int i, pg8::Unit& u) const {
        const int L = i * G + c, TR = RFL(tab[64]);
        if (L < TR) { const int e = moe_find(tab, L), ti = L - RFL(tab[e]); u.pm = L; u.pn = ti; u.aux = e; u.A = xn2; u.B = wegu + (size_t)e * 256 * 2048; u.rows = list_tok + (size_t)e * EXP_CAP + ti * 256;
            const int left = RFL(tab[128 + e]) - ti * 256; u.nrows = left < 256 ? left : 256; return true; }
        const int s = L - TR; if (s >= (NTOK / 256) * 2) return false;
        u.pm = s >> 1; u.pn = s & 1; u.aux = 64 + (s & 1); u.A = xn2; u.B = wsgu + (size_t)(s & 1) * 256 * 2048; u.rows = ident + u.pm * 256; u.nrows = 256; return true; } };
struct EpiGu { static constexpr bool PERM = false; bf16* hid; bf16* hsh; const float* list_w;
    __device__ __forceinline__ void operator()(const f32x4 (&acc)[2][2][4][2], const pg8::Unit& u, int wr, int wc, int fr, int fq) const {
        const bool routed = u.aux < 64;
#pragma unroll
        for (int ai = 0; ai < 2; ++ai)
#pragma unroll
            for (int mm = 0; mm < 4; ++mm) { const int row = ai * 128 + wr * 64 + mm * 16 + fr;
                float w = 1.f; bf16* dst;
                if (routed) { const bool live = row < u.nrows; w = live ? list_w[(size_t)u.aux * EXP_CAP + u.pn * 256 + row] : 0.f; dst = hid + ((size_t)u.pm * 256 + row) * EXP_D + 32 * wc + 4 * fq; }
                else dst = hsh + ((size_t)u.pm * 256 + row) * SH_D + (u.aux - 64) * 128 + 32 * wc + 4 * fq;
#pragma unroll
                for (int n = 0; n < 2; ++n) { const f32x4 g4 = acc[ai][0][mm][n], u4 = acc[ai][1][mm][n]; f32x4 o;
#pragma unroll
                    for (int j = 0; j < 4; ++j) o[j] = g4[j] * fsig(g4[j]) * u4[j] * w;
                    *(v2u*)(dst + 16 * n) = pack4(o); }
                asm volatile("" ::: "memory"); }
    } };
struct DownOrder { const LAS int* tab; const char* hid; const char* wed; const int* list_row; int G, c, half;
    __device__ __forceinline__ bool next(int i, pg8::Unit& u) const {
        const int L = i * G + c, TR = RFL(tab[64]); if (L >= 2 * TR) return false;
        const int tile = L >> 1, j = L & 1, e = moe_find(tab, tile), ti = tile - RFL(tab[e]);
        u.pm = tile; u.pn = j; u.aux = e; u.A = hid + (size_t)tile * 256 * (EXP_D * 2); u.B = wed + ((size_t)e * D_MODEL + (half * 2 + j) * 256) * (EXP_D * 2);
        u.rows = list_row + (size_t)e * EXP_CAP + ti * 256; const int left = RFL(tab[128 + e]) - ti * 256; u.nrows = left < 256 ? left : 256; return true; } };
struct EpiDownR { static constexpr bool PERM = false; bf16* yslot;
    __device__ __forceinline__ void operator()(const f32x4 (&acc)[2][2][4][2], const pg8::Unit& u, int wr, int wc, int fr, int fq) const {
#pragma unroll
        for (int ai = 0; ai < 2; ++ai)
#pragma unroll
            for (int mm = 0; mm < 4; ++mm) { const int row = ai * 128 + wr * 64 + mm * 16 + fr;
                if (row < u.nrows) { bf16* dst = yslot + (size_t)u.rows[row] * YS_W + u.pn * 256 + 32 * wc + 4 * fq;
#pragma unroll
                    for (int bj = 0; bj < 2; ++bj)
#pragma unroll
                        for (int n = 0; n < 2; ++n) *(v2u*)(dst + 128 * bj + 16 * n) = pack4(acc[ai][bj][mm][n]); }
                asm volatile("" ::: "memory"); }
    } };
struct EpiBf16Store { static constexpr bool PERM = false; bf16* o; int ld;
    __device__ __forceinline__ void operator()(const f32x4 (&acc)[2][2][4][2], const pg8::Unit& u, int wr, int wc, int fr, int fq) const {
        EPI_WALK(u, { *(v2u*)(o + (size_t)r * ld + col) = pack4(a4); }); } };
template <int HALF_>
__device__ __forceinline__ void moe_combine_row(float* hrow, bf16* yshrow  , const bf16* ys  , int lane) {
    const int c = HALF_ * YS_W + lane * 8;
    f32x4 a0 = *(const f32x4*)(hrow + c), a1 = *(const f32x4*)(hrow + c + 4);
    { const v4u s = *(const v4u*)(yshrow + c); const f32x4 lo = unpack4((v2u){s.x, s.y}), hi = unpack4((v2u){s.z, s.w}); a0 += lo; a1 += hi; }
#pragma unroll
    for (int k = 0; k < TOP_K; ++k) { const v4u s = *(const v4u*)(ys + (size_t)k * YS_W + lane * 8); a0 += unpack4((v2u){s.x, s.y}); a1 += unpack4((v2u){s.z, s.w}); }
    *(f32x4*)(hrow + c) = a0; *(f32x4*)(hrow + c + 4) = a1;
    if (HALF_ == 1) {
        const f32x4 b0 = *(const f32x4*)(hrow + lane * 8), b1 = *(const f32x4*)(hrow + lane * 8 + 4);
        float ss = 0.f;
#pragma unroll
        for (int j = 0; j < 4; ++j) ss += a0[j] * a0[j] + a1[j] * a1[j] + b0[j] * b0[j] + b1[j] * b1[j];
        const float rs = rsqrtf(wave_sum(ss) * (1.f / D_MODEL) + EPS);
        asm volatile("" ::: "memory");
        *(v4u*)(yshrow + lane * 8) = (v4u){cvt_pk_bf16(b0.x * rs, b0.y * rs), cvt_pk_bf16(b0.z * rs, b0.w * rs), cvt_pk_bf16(b1.x * rs, b1.y * rs), cvt_pk_bf16(b1.z * rs, b1.w * rs)};
        *(v4u*)(yshrow + c) = (v4u){cvt_pk_bf16(a0.x * rs, a0.y * rs), cvt_pk_bf16(a0.z * rs, a0.w * rs), cvt_pk_bf16(a1.x * rs, a1.y * rs), cvt_pk_bf16(a1.z * rs, a1.w * rs)};
    }
}
struct EpiPle { static constexpr bool PERM = false; float* h; const bf16* pp;
    __device__ __forceinline__ void operator()(const f32x4 (&acc)[2][2][4][2], const pg8::Unit& u, int wr, int wc, int fr, int fq) const {
        EPI_WALK(u, { const size_t o = (size_t)r * D_MODEL + col; const f32x4 pv = unpack4(*(const v2u*)(pp + o)); f32x4 hv = *(const f32x4*)(h + o);
            hv.x += fsig(a4.x) * pv.x; hv.y += fsig(a4.y) * pv.y; hv.z += fsig(a4.z) * pv.z; hv.w += fsig(a4.w) * pv.w; *(f32x4*)(h + o) = hv; }); } };
constexpr int PH_PROLOGUE = 0, PH_INPROJ = 1, PH_SSTATE = 2, PH_SCARRY = 3, PH_ATTN = 4, PH_GLU = 5, PH_MERGE_A = 6, PH_MERGE_B = 7, PH_OUTPROJ = 8, PH_ROUTE = 9, PH_EXP_GU = 10, PH_DOWN_A = 11, PH_COMB_A = 12, PH_DOWN_B = 13, PH_COMB_B = 14, PH_PLE_PP = 15, PH_PLE_GATE = 16, PH_FINAL = 17, PH_END = 18;
__global__ void __launch_bounds__(NWAVES * 64, 2) mk_fwd(Args args) {
    __shared__ __attribute__((aligned(16))) unsigned char lds_raw[LDS_BYTES];
    LAS unsigned char* lds = (LAS unsigned char*)lds_raw;
    volatile LAS unsigned* MISC = (volatile LAS unsigned*)(lds + MISC_OFF);
    const int tid0 = threadIdx.x, wave = __builtin_amdgcn_readfirstlane(tid0 >> 6);
#define FRESH_IDS() int tid = tid0; asm volatile("" : "+v"(tid)); const int lane = tid & 63; (void)lane
    const int G = gridDim.x; const int bx = blockIdx.x; const int vcu = (G % 8 == 0) ? (bx % 8) * (G / 8) + bx / 8 : bx;
    unsigned char* ws = args.ws;
    gu32* ctl = (gu32*)(ws + WS_CTL);
    { FRESH_IDS(); for (int u = tid; u < (LDS_BYTES - LDSCTL_OFF) / 4; u += NWAVES * 64) ((LAS unsigned*)(lds + LDSCTL_OFF))[u] = 0u; }
    __syncthreads();
    XcdBarrier bar = xcd_barrier_post((unsigned*)(ctl + CW_BAR) + args.li * XCD_BAR_WORDS, MISC + 8);
    const int lo = args.ph_lo, hi = args.ph_hi;
#define IN(k) (lo <= (k) && (k) < hi)
#define BOTH(k) (IN(k) && IN((k) + 1))
#define GRID_BAR() xcd_barrier(bar)
    const float* x = args.in[0];
    bf16* XB = (bf16*)(ws + WS_XB); float* rstd1 = (float*)(ws + WS_RSTD1); float* rope = (float*)(ws + WS_ROPE);
    bf16* Win_t = (bf16*)(ws + WS_WIN);

    if (IN(PH_PROLOGUE)) { FRESH_IDS();
        LAS float* scr = (LAS float*)(lds + RING_OFF + wave * 16384);
        const int gw = vcu * NWAVES + wave, NGW = G * NWAVES;
        {
            int base = 0;
            for (int jb = 0; jb < N_TRJOBS; ++jb) { const TrJob t = p0_job(args, jb); const int per = (t.K / 64) * (t.N / 32), tot = per * t.nmat;
                int first = gw - (base % NGW); if (first < 0) first += NGW;
                for (int it = first; it < tot; it += NGW) { const int mi = it / per, sub = it - mi * per;
                    p0_transpose_item(t.W + (size_t)mi * t.K * t.N, t.K, t.N, t.gain, t.WT, t.ldt, t.row_off + mi * t.rows_per_mat, t.mode, scr, sub, lane); }
                base += tot; }
            bf16* wr = (bf16*)(ws + WS_WROUTER); int* ident = (int*)(ws + WS_IDENT);
            for (int e = vcu * (NWAVES * 64) + tid; e < N_EXP * D_MODEL; e += G * NWAVES * 64) { const int ex = e >> 10, k = e & 1023; const float v = args.in[20][(size_t)k * N_EXP + ex] * args.in[19][k];
                const bf16 hi = f2bf(v); wr[(size_t)ex * D_MODEL + k] = hi; wr[(size_t)(64 + ex) * D_MODEL + k] = f2bf(v - bf2f(hi)); }
            for (int e = vcu * (NWAVES * 64) + tid; e < NTOK; e += G * NWAVES * 64) ident[e] = e;
        }
        for (int m = gw; m < NTOK; m += NGW) row_to_bf16_rstd(x + (size_t)m * D_MODEL, XB + (size_t)m * D_MODEL, rstd1 + m, lane);
        { const SsmIn SP{args.in[7], args.in[8], args.in[9], args.in[10], args.in[11], args.in[12], args.in[13], args.in[14]};
          bf16* btcat = (bf16*)(ws + WS_BTCAT); bf16* btst = (bf16*)(ws + WS_BTST);
          for (int it = NGW - 1 - gw; it < SSM_ITEMS; it += NGW) {
              if (it < SSM_I_TOEP) ssm_item_toep(SP, btcat, scr, it, lane);
              else if (it < SSM_I_TOEP + SSM_I_OUT) ssm_item_out(SP, btcat, it - SSM_I_TOEP, lane);
              else ssm_item_state(SP, btst, it - SSM_I_TOEP - SSM_I_OUT, lane); } }
        if (bx == 0) for (int e = tid; e < 64 * 16; e += NWAVES * 64) { const int coord = e >> 4, i = e & 15; const float invf = powf(10000.f, -(float)(2 * i) / 32.f);
            rope[2 * e] = cosf((float)coord * invf); rope[2 * e + 1] = sinf((float)coord * invf); }
        if (BOTH(PH_PROLOGUE)) GRID_BAR();
    }
    if (IN(PH_INPROJ)) {
        pg8::Desc g{D_MODEL, D_MODEL * 2, D_MODEL * 2};
        pg8::PlainOrder S{(const char*)XB, (const char*)Win_t, NTOK / 256, IN_W / 256, G, bx, D_MODEL * 2, D_MODEL * 2};
        EpiInProj E{rstd1, rope, args.in[4], args.in[5], (bf16*)(ws + WS_Q), (bf16*)(ws + WS_K), (bf16*)(ws + WS_V), (bf16*)(ws + WS_UCAT), (bf16*)(ws + WS_GA), (bf16*)(ws + WS_GS)};
        pg8::gemm_run<EpiInProj, pg8::PlainOrder, true, false>(lds + RING_OFF, g, S, E);
        if (BOTH(PH_INPROJ)) GRID_BAR();
    }
    if (IN(PH_SSTATE)) {
        pg8::Desc g{1024, UCAT_LD * 2, 2048};
        StateOrder S{(const char*)(ws + WS_UCAT), (const char*)(ws + WS_BTST), G, bx};
        EpiState E{(float*)(ws + WS_LST)};
        pg8::gemm_run<EpiState, StateOrder, true, false>(lds + RING_OFF, g, S, E);
        if (BOTH(PH_SSTATE)) GRID_BAR();
    }
    if (IN(PH_SCARRY)) { FRESH_IDS();
        const SsmIn SP{args.in[7], args.in[8], args.in[9], args.in[10], args.in[11], args.in[12], args.in[13], args.in[14]};
        for (int idx = vcu * (NWAVES * 64) + tid; idx < SSM_NG * BATCH * 2 * SSM_P; idx += G * NWAVES * 64) ssm_carry(SP, (const float*)(ws + WS_LST), (bf16*)(ws + WS_UCAT), idx);
        if (BOTH(PH_SCARRY)) GRID_BAR();
    }
    if (IN(PH_ATTN)) {
        static_assert(attn_body::ATTN_LDS_BYTES <= RING_BYTES, "attention scratch vs ring");
        const attn_body::AttnTensors AT{(const attn_body::bf16*)(ws + WS_Q), (const attn_body::bf16*)(ws + WS_K), (const attn_body::bf16*)(ws + WS_V), (attn_body::bf16*)(ws + WS_O)};
        const attn_body::StaticOrder S(G, vcu);
        { pg8::Desc g{UCAT_LD, UCAT_LD * 2, UCAT_LD * 2};
          YOrder SY{(const char*)(ws + WS_UCAT), (const char*)(ws + WS_BTCAT), G, bx};
          EpiY EY{(bf16*)(ws + WS_YACT)};
          pg8::gemm_run<EpiY, YOrder, true, false>(lds + RING_OFF, g, SY, EY); }
        attn_body::attn_phase<attn_body::StaticOrder>((char*)lds_raw + RING_OFF, AT, S);
        if (BOTH(PH_ATTN)) GRID_BAR();
    }
    if (IN(PH_GLU)) {
        pg8::Desc g{SSM_W, SSM_W * 2, SSM_W * 2};
        pg8::PlainOrder S{(const char*)(ws + WS_YACT), (const char*)(ws + WS_WGLU), NTOK / 256, 1, G, bx, SSM_W * 2, SSM_W * 2};
        EpiGlu E{(bf16*)(ws + WS_YACT), args.in[16]};
        pg8::gemm_run<EpiGlu, pg8::PlainOrder, true, false>(lds + RING_OFF, g, S, E);
        if (BOTH(PH_GLU)) GRID_BAR();
    }
    if (IN(PH_MERGE_A)) {
        pg8::Desc g{Q_W, Q_W * 2, Q_W * 2};
        pg8::PlainOrder S{(const char*)(ws + WS_O), (const char*)(ws + WS_WAU), NTOK / 256, D_MODEL / 256, G, bx, Q_W * 2, Q_W * 2};
        EpiMerge<true> E{(bf16*)(ws + WS_GA), (const bf16*)(ws + WS_GA)};
        pg8::gemm_run<EpiMerge<true>, pg8::PlainOrder, true, false>(lds + RING_OFF, g, S, E);
        if (BOTH(PH_MERGE_A)) GRID_BAR();
    }
    if (IN(PH_MERGE_B)) {
        pg8::Desc g{SSM_W, SSM_W * 2, SSM_W * 2};
        pg8::PlainOrder S{(const char*)(ws + WS_YACT), (const char*)(ws + WS_WSU), NTOK / 256, D_MODEL / 256, G, bx, SSM_W * 2, SSM_W * 2};
        EpiMerge<false> E{(bf16*)(ws + WS_GA), (const bf16*)(ws + WS_GS)};
        pg8::gemm_run<EpiMerge<false>, pg8::PlainOrder, true, false>(lds + RING_OFF, g, S, E);
        if (BOTH(PH_MERGE_B)) GRID_BAR();
    }
    if (IN(PH_OUTPROJ)) {
        pg8::Desc g{D_MODEL, D_MODEL * 2, D_MODEL * 2};
        pg8::PlainOrder S{(const char*)(ws + WS_GA), (const char*)(ws + WS_WOUT), NTOK / 256, D_MODEL / 256, G, bx, D_MODEL * 2, D_MODEL * 2};
        EpiResid E{x, args.out};
        pg8::gemm_run<EpiResid, pg8::PlainOrder, true, false>(lds + RING_OFF, g, S, E);
        if (BOTH(PH_OUTPROJ)) GRID_BAR();
    }
    MoeBufs MB; MB.xn2 = (bf16*)(ws + WS_XN2); MB.logit = (float*)(ws + WS_LOGIT); MB.cnt = (int*)(ws + WS_CTL) + CW_CNT; MB.list_tok = (int*)(ws + WS_LTOK); MB.list_w = (float*)(ws + WS_LW);
    MB.list_row = (int*)(ws + WS_LROW); MB.ident = (const int*)(ws + WS_IDENT); MB.hid = (bf16*)(ws + WS_HID); MB.hsh = (bf16*)(ws + WS_HSH); MB.yslot = (bf16*)(ws + WS_YSLOT); MB.ysh = (bf16*)(ws + WS_XN2);
    LAS int* tab = (LAS int*)(lds + LDS_TAB_OFF);
    if (IN(PH_ROUTE)) { FRESH_IDS();
        for (int rt = bx; rt < NTOK / 256; rt += G)
            for (int i = 0; i < 32; ++i) { const size_t t = (size_t)rt * 256 + wave * 32 + i; row_norm_bf16(args.out + t * D_MODEL, MB.xn2 + t * D_MODEL, lane); }
        VM_WAIT(); __syncthreads();
        { pg8::Desc g{D_MODEL, D_MODEL * 2, D_MODEL * 2};
          OneTileOrder S{(const char*)MB.xn2, (const char*)(ws + WS_WROUTER), G, bx, NTOK / 256, D_MODEL * 2};
          EpiRouter E{MB.logit};
          pg8::gemm_run<EpiRouter, OneTileOrder, false, false>(lds + RING_OFF, g, S, E); }
        VM_WAIT(); __syncthreads();
        for (int rt = bx; rt < NTOK / 256; rt += G) {
            if (tid < 64) { tab[256 + tid] = 0; tab[384 + tid] = 0; }
            __syncthreads();
            int idx[8]; float wgt[8]; const int t = rt * 256 + tid;
            if (tid < 256) { route_token(MB.logit + (size_t)t * 128, args.in[21], idx, wgt);
#pragma unroll
                for (int k = 0; k < TOP_K; ++k) __hip_atomic_fetch_add(tab + 256 + idx[k], 1, __ATOMIC_RELAXED, __HIP_MEMORY_SCOPE_WORKGROUP); }
            __syncthreads();
            if (tid < 64) tab[320 + tid] = __hip_atomic_fetch_add(MB.cnt + tid, tab[256 + tid], __ATOMIC_RELAXED, __HIP_MEMORY_SCOPE_AGENT);
            __syncthreads();
            if (tid < 256) {
#pragma unroll
                for (int k = 0; k < TOP_K; ++k) { const int e = idx[k]; const int lp = tab[320 + e] + __hip_atomic_fetch_add(tab + 384 + e, 1, __ATOMIC_RELAXED, __HIP_MEMORY_SCOPE_WORKGROUP);
                    const size_t o = (size_t)e * EXP_CAP + lp; MB.list_tok[o] = t; MB.list_w[o] = wgt[k]; MB.list_row[o] = t * TOP_K + k; } }
            __syncthreads();
        }
        if (BOTH(PH_ROUTE)) GRID_BAR();
    }
    if (IN(PH_EXP_GU)) { FRESH_IDS();
        moe_build_tab(tab, MB.cnt, tid);
        pg8::Desc g{D_MODEL, D_MODEL * 2, D_MODEL * 2};
        GuOrder S{tab, (const char*)MB.xn2, (const char*)(ws + WS_WEGU), (const char*)(ws + WS_WSGU), MB.list_tok, MB.ident, G, bx};
        EpiGu E{MB.hid, MB.hsh, MB.list_w};
        pg8::gemm_run<EpiGu, GuOrder, true, true>(lds + RING_OFF, g, S, E);
        if (BOTH(PH_EXP_GU)) GRID_BAR();
    }
    if (IN(PH_DOWN_A)) { FRESH_IDS();
        moe_build_tab(tab, MB.cnt, tid);
        { pg8::Desc g{EXP_D, EXP_D * 2, EXP_D * 2};
          DownOrder S{tab, (const char*)MB.hid, (const char*)(ws + WS_WED), MB.list_row, G, bx, 0};
          EpiDownR E{MB.yslot};
          pg8::gemm_run<EpiDownR, DownOrder, true, false>(lds + RING_OFF, g, S, E); }
        { pg8::Desc g{SH_D, SH_D * 2, SH_D * 2};
          pg8::PlainOrder S{(const char*)MB.hsh, (const char*)(ws + WS_WSD), NTOK / 256, D_MODEL / 256, G, bx, SH_D * 2, SH_D * 2};
          EpiBf16Store E{MB.ysh, D_MODEL};
          pg8::gemm_run<EpiBf16Store, pg8::PlainOrder, true, false>(lds + RING_OFF, g, S, E); }
        if (BOTH(PH_DOWN_A)) GRID_BAR();
    }
    if (IN(PH_COMB_A)) { FRESH_IDS();
        const int gw = vcu * NWAVES + wave, NGW = G * NWAVES;
        for (int t = gw; t < NTOK; t += NGW) moe_combine_row<0>(args.out + (size_t)t * D_MODEL, MB.ysh + (size_t)t * D_MODEL, MB.yslot + (size_t)t * TOP_K * YS_W, lane);
        if (BOTH(PH_COMB_A)) GRID_BAR();
    }
    if (IN(PH_DOWN_B)) { FRESH_IDS();
        moe_build_tab(tab, MB.cnt, tid);
        pg8::Desc g{EXP_D, EXP_D * 2, EXP_D * 2};
        DownOrder S{tab, (const char*)MB.hid, (const char*)(ws + WS_WED), MB.list_row, G, bx, 1};
        EpiDownR E{MB.yslot};
        pg8::gemm_run<EpiDownR, DownOrder, true, false>(lds + RING_OFF, g, S, E);
        if (BOTH(PH_DOWN_B)) GRID_BAR();
    }
    if (IN(PH_COMB_B)) { FRESH_IDS();
        const int gw = vcu * NWAVES + wave, NGW = G * NWAVES;
        for (int t = gw; t < NTOK; t += NGW) moe_combine_row<1>(args.out + (size_t)t * D_MODEL, MB.ysh + (size_t)t * D_MODEL, MB.yslot + (size_t)t * TOP_K * YS_W, lane);
        bf16* pb = (bf16*)(ws + WS_HID);
        for (int t = gw; t < NTOK; t += NGW) { const f32x4 v = *((const GAS f32x4*)(args.in[1] + (size_t)t * PLE_D) + lane); *((GAS v2u*)(pb + (size_t)t * PLE_D) + lane) = (v2u){cvt_pk_bf16(v.x, v.y), cvt_pk_bf16(v.z, v.w)}; }
        if (BOTH(PH_COMB_B)) GRID_BAR();
    }
    if (IN(PH_PLE_PP)) {
        pg8::Desc g{PLE_D, PLE_D * 2, PLE_D * 2};
        pg8::PlainOrder S{(const char*)(ws + WS_HID), (const char*)(ws + WS_WPP), NTOK / 256, D_MODEL / 256, G, bx, PLE_D * 2, PLE_D * 2};
        EpiBf16Store E{(bf16*)(ws + WS_YSLOT), D_MODEL};
        pg8::gemm_run<EpiBf16Store, pg8::PlainOrder, true, false>(lds + RING_OFF, g, S, E);
        if (BOTH(PH_PLE_PP)) GRID_BAR();
    }
    if (IN(PH_PLE_GATE)) {
        pg8::Desc g{D_MODEL, D_MODEL * 2, D_MODEL * 2};
        pg8::PlainOrder S{(const char*)(ws + WS_XN3), (const char*)(ws + WS_WPG), NTOK / 256, D_MODEL / 256, G, bx, D_MODEL * 2, D_MODEL * 2};
        EpiPle E{args.out, (const bf16*)(ws + WS_YSLOT)};
        pg8::gemm_run<EpiPle, pg8::PlainOrder, true, false>(lds + RING_OFF, g, S, E);
        if (BOTH(PH_PLE_GATE)) GRID_BAR();
    }
    if (IN(PH_FINAL)) { FRESH_IDS();
        const int gw = vcu * NWAVES + wave, NGW = G * NWAVES;
        for (int t = gw; t < NTOK; t += NGW) { GAS f32x4* hr = (GAS f32x4*)(args.out + (size_t)t * D_MODEL) + lane; f32x4 v[4]; float ss = 0.f;
#pragma unroll
            for (int j = 0; j < 4; ++j) { v[j] = hr[64 * j]; ss += (v[j].x * v[j].x + v[j].y * v[j].y) + (v[j].z * v[j].z + v[j].w * v[j].w); }
            const float rs = rsqrtf(wave_sum(ss) * (1.f / D_MODEL) + EPS);
#pragma unroll
            for (int j = 0; j < 4; ++j) { const f32x4 gg = *((const GAS f32x4*)args.in[31] + lane + 64 * j); hr[64 * j] = v[j] * rs * gg; } }
    }
#undef IN
#undef BOTH
#undef GRID_BAR
}
template <class AL, class EP>
__global__ void __launch_bounds__(256) ngemm(AL al, EP ep, const int* Mz, const float* __restrict__ B, size_t strideB, int M, int N, int K, int ldb) {
    __shared__ float As[16][68];
    __shared__ float Bs[16][68];
    const int z = blockIdx.z;
    const int Mv = Mz ? Mz[z] : M;
    const int r0 = blockIdx.y * 64, c0 = blockIdx.x * 64;
    if (r0 >= Mv) return;
    const float* Bz = B + (size_t)z * strideB;
    const int tid = threadIdx.x, tx = tid & 15, ty = tid >> 4;
    float acc[4][4];
#pragma unroll
    for (int i = 0; i < 4; ++i)
#pragma unroll
        for (int j = 0; j < 4; ++j) acc[i][j] = 0.f;
    for (int k0 = 0; k0 < K; k0 += 16) {
#pragma unroll
        for (int i = 0; i < 4; ++i) {
            const int e = tid + i * 256, kk = e & 15, rr = e >> 4;
            const int r = r0 + rr;
            As[kk][rr] = (r < Mv) ? al.a(z, r, k0 + kk) : 0.f;
        }
#pragma unroll
        for (int i = 0; i < 4; ++i) {
            const int e = tid + i * 256, cc = e & 63, kk = e >> 6;
            Bs[kk][cc] = Bz[(size_t)(k0 + kk) * ldb + c0 + cc];
        }
        __syncthreads();
#pragma unroll
        for (int kk = 0; kk < 16; ++kk) {
            float a[4], b[4];
#pragma unroll
            for (int i = 0; i < 4; ++i) { a[i] = As[kk][ty * 4 + i]; b[i] = Bs[kk][tx * 4 + i]; }
#pragma unroll
            for (int i = 0; i < 4; ++i)
#pragma unroll
                for (int j = 0; j < 4; ++j) acc[i][j] += a[i] * b[j];
        }
        __syncthreads();
    }
#pragma unroll
    for (int i = 0; i < 4; ++i) {
        const int r = r0 + ty * 4 + i;
        if (r < Mv) {
#pragma unroll
            for (int j = 0; j < 4; ++j) ep.put(z, r, c0 + tx * 4 + j, acc[i][j]);
        }
    }
}
template <class AL, class EP>
static void launch_ngemm(hipStream_t s, int M, const int* Mz, int Mmax, int N, int K, int Z, AL al, const float* B, size_t strideB, int ldb, EP ep) {
    dim3 g(N / 64, (Mmax + 63) / 64, Z);
    hipLaunchKernelGGL((ngemm<AL, EP>), g, dim3(256), 0, s, al, ep, Mz, B, strideB, M, N, K, ldb);
}

struct AL_f32 { const float* A; int lda; int pad; __device__ float a(int, int r, int k) const { return A[(size_t)r * lda + k]; } };
struct AL_f32g { const float* A; const float* g; int lda; int pad; __device__ float a(int, int r, int k) const { return A[(size_t)r * lda + k] * g[k]; } };
struct AL_bf16 { const bf16* A; int lda; int pad; __device__ float a(int, int r, int k) const { return bf2f(A[(size_t)r * lda + k]); } };
struct AL_gather { const float* A; const int* list; int lda; int cap; __device__ float a(int z, int r, int k) const { return A[(size_t)list[(size_t)z * cap + r] * lda + k]; } };
struct AL_slot { const float* A; const int* base; int lda; int pad; __device__ float a(int z, int r, int k) const { return A[(size_t)(base[z] + r) * lda + k]; } };

__global__ void __launch_bounds__(256) k_rstd(const float* __restrict__ x, float* __restrict__ rstd, int rows) {
    const int row = blockIdx.x * 4 + (threadIdx.x >> 6), lane = threadIdx.x & 63;
    if (row >= rows) return;
    const float4* xr = (const float4*)(x + (size_t)row * D_MODEL);
    float s = 0.f;
#pragma unroll
    for (int j = 0; j < 4; ++j) { const float4 v = xr[lane + 64 * j]; s += v.x * v.x + v.y * v.y + v.z * v.z + v.w * v.w; }
    s = wave_sum(s);
    if (lane == 0) rstd[row] = rsqrtf(s * (1.f / D_MODEL) + EPS);
}
__global__ void __launch_bounds__(256) k_rownorm_f32(const float* __restrict__ x, const float* __restrict__ g, float* __restrict__ out, int rows) {
    const int row = blockIdx.x * 4 + (threadIdx.x >> 6), lane = threadIdx.x & 63;
    if (row >= rows) return;
    const float4* xr = (const float4*)(x + (size_t)row * D_MODEL);
    float4 v[4]; float s = 0.f;
#pragma unroll
    for (int j = 0; j < 4; ++j) { v[j] = xr[lane + 64 * j]; s += v[j].x * v[j].x + v[j].y * v[j].y + v[j].z * v[j].z + v[j].w * v[j].w; }
    const float r = rsqrtf(wave_sum(s) * (1.f / D_MODEL) + EPS);
    float4* o = (float4*)(out + (size_t)row * D_MODEL);
#pragma unroll
    for (int j = 0; j < 4; ++j) { const float4 gg = ((const float4*)g)[lane + 64 * j]; o[lane + 64 * j] = make_float4(v[j].x * r * gg.x, v[j].y * r * gg.y, v[j].z * r * gg.z, v[j].w * r * gg.w); }
}
__global__ void __launch_bounds__(256) k_combine(float* __restrict__ h, const float* __restrict__ acc, bf16* __restrict__ xn3, int rows) {
    const int row = blockIdx.x * 4 + (threadIdx.x >> 6), lane = threadIdx.x & 63;
    if (row >= rows) return;
    float4* hr = (float4*)(h + (size_t)row * D_MODEL);
    const float4* ar = (const float4*)(acc + (size_t)row * D_MODEL);
    float4 v[4]; float s = 0.f;
#pragma unroll
    for (int j = 0; j < 4; ++j) { const float4 a = hr[lane + 64 * j], b = ar[lane + 64 * j]; v[j] = make_float4(a.x + b.x, a.y + b.y, a.z + b.z, a.w + b.w);
        s += v[j].x * v[j].x + v[j].y * v[j].y + v[j].z * v[j].z + v[j].w * v[j].w; }
    const float r = rsqrtf(wave_sum(s) * (1.f / D_MODEL) + EPS);
#pragma unroll
    for (int j = 0; j < 4; ++j) { hr[lane + 64 * j] = v[j];
        bf16* o = xn3 + (size_t)row * D_MODEL + (lane + 64 * j) * 4;
        o[0] = f2bf(v[j].x * r); o[1] = f2bf(v[j].y * r); o[2] = f2bf(v[j].z * r); o[3] = f2bf(v[j].w * r); }
}

struct EP_inproj { const float* rstd; float* qk; bf16* V; bf16* ucat; bf16* ga; bf16* gs;
    __device__ void put(int, int r, int c, float acc) const {
        const float v = acc * rstd[r];
        if (c < 640) qk[(size_t)r * 640 + c] = v;
        else if (c < 768) V[(size_t)r * KV_W + (c - 640)] = f2bf(v);
        else if (c < 1024) { const int cu = c - 768, g = cu >> 4, ch = cu & 15, b = r / SEQ, t = r % SEQ;
            ucat[((size_t)g * (BATCH * NCHUNK) + b * NCHUNK + t / CH_T) * UCAT_LD + (t % CH_T) * SSM_G + ch] = f2bf(v); }
        else if (c < 2048) ga[(size_t)r * D_MODEL + (c - 1024)] = f2bf(sigmoidf_(v));
        else gs[(size_t)r * D_MODEL + (c - 2048)] = f2bf(sigmoidf_(v));
    } };
__global__ void __launch_bounds__(256) k_qknorm(const float* __restrict__ qk, const float* __restrict__ qn, const float* __restrict__ kn, bf16* __restrict__ Q, bf16* __restrict__ K) {
    const int idx = blockIdx.x * 256 + threadIdx.x;
    if (idx >= NTOK * 10) return;
    const int r = idx / 10, j = idx % 10;
    const float* src = qk + (size_t)r * 640 + j * 64;
    float y[64]; float s = 0.f;
#pragma unroll
    for (int d = 0; d < 64; ++d) { y[d] = src[d]; s += y[d] * y[d]; }
    const float rs = rsqrtf(s * (1.f / 64.f) + EPS);
    const float* w = (j < 8) ? qn : kn;
#pragma unroll
    for (int d = 0; d < 64; ++d) y[d] = y[d] * rs * w[d];
    const int pos = r % SEQ; const float row = (float)(pos / 64), col = (float)(pos % 64);
    float o[64];
#pragma unroll
    for (int i = 0; i < 16; ++i) {
        const float invf = powf(10000.f, -(float)(2 * i) / 32.f);
        float sr, cr, sc, cc; sincosf(row * invf, &sr, &cr); sincosf(col * invf, &sc, &cc);
        o[i] = y[i] * cr - y[i + 16] * sr; o[i + 16] = y[i + 16] * cr + y[i] * sr;
        o[32 + i] = y[32 + i] * cc - y[48 + i] * sc; o[48 + i] = y[48 + i] * cc + y[32 + i] * sc;
    }
    if (j < 8) { bf16* dst = Q + (size_t)r * Q_W + j * 64;
#pragma unroll
        for (int d = 0; d < 64; ++d) dst[d] = f2bf(o[d] * C2); }
    else { bf16* dst = K + (size_t)r * KV_W + (j - 8) * 64;
#pragma unroll
        for (int d = 0; d < 64; ++d) dst[d] = f2bf(o[d]); }
}

__global__ void __launch_bounds__(256) k_attn_naive(const bf16* __restrict__ Q, const bf16* __restrict__ K, const bf16* __restrict__ V, bf16* __restrict__ O) {
    const int qb = blockIdx.x & 7, h = (blockIdx.x >> 3) & 7, b = blockIdx.x >> 6;
    const int r = b * SEQ + qb * 256 + threadIdx.x, kvh = h / (N_HEADS / N_KV);
    float q[64], o[64];
#pragma unroll
    for (int d = 0; d < 64; ++d) { q[d] = bf2f(Q[(size_t)r * Q_W + h * 64 + d]); o[d] = 0.f; }
    float m = -INFINITY, l = 0.f;
    const bf16* Kb = K + (size_t)b * SEQ * KV_W + kvh * 64; const bf16* Vb = V + (size_t)b * SEQ * KV_W + kvh * 64;
    for (int j = 0; j < SEQ; ++j) {
        const bf16* kr = Kb + (size_t)j * KV_W; const bf16* vr = Vb + (size_t)j * KV_W;
        float s = 0.f;
#pragma unroll
        for (int d = 0; d < 64; ++d) s += q[d] * bf2f(kr[d]);
        if (s > m) { const float sc = exp2f(m - s); l *= sc;
#pragma unroll
            for (int d = 0; d < 64; ++d) o[d] *= sc;
            m = s; }
        const float p = exp2f(s - m); l += p;
#pragma unroll
        for (int d = 0; d < 64; ++d) o[d] += p * bf2f(vr[d]);
    }
    const float il = 1.f / l;
#pragma unroll
    for (int d = 0; d < 64; ++d) O[(size_t)r * Q_W + h * 64 + d] = f2bf(o[d] * il);
}

__global__ void __launch_bounds__(64) k_ssm_naive(const bf16* __restrict__ ucat, const float* __restrict__ a_re, const float* __restrict__ a_im, const float* __restrict__ log_dt,
                                                  const float* __restrict__ b_re, const float* __restrict__ b_im, const float* __restrict__ c_re, const float* __restrict__ c_im,
                                                  const float* __restrict__ d_skip, float* __restrict__ ytmp, bf16* __restrict__ yact) {
    const int g = blockIdx.x & 15, b = blockIdx.x >> 4, p = threadIdx.x;
    for (int dir = 0; dir < 2; ++dir) {
        const int gi = dir * SSM_NG + g;
        const float are = a_re[gi * SSM_P + p], aim = a_im[gi * SSM_P + p], dt = expf(log_dt[gi]);
        const float mag = expf(are * dt); float sn, cs; sincosf(aim * dt, &sn, &cs);
        const float abr = mag * cs, abi = mag * sn;
        const float nr = abr - 1.f, ni = abi, den = are * are + aim * aim;
        const float cfr = (nr * are + ni * aim) / den, cfi = (ni * are - nr * aim) / den;
        float bbr[16], bbi[16], cr[16], ci[16];
#pragma unroll
        for (int c = 0; c < 16; ++c) {
            const float br = b_re[((size_t)gi * SSM_P + p) * SSM_G + c], bi = b_im[((size_t)gi * SSM_P + p) * SSM_G + c];
            bbr[c] = cfr * br - cfi * bi; bbi[c] = cfr * bi + cfi * br;
            cr[c] = c_re[((size_t)gi * SSM_G + c) * SSM_P + p]; ci[c] = c_im[((size_t)gi * SSM_G + c) * SSM_P + p];
        }
        float sr = 0.f, si = 0.f;
        for (int tt = 0; tt < SEQ; ++tt) {
            const int t = dir ? (SEQ - 1 - tt) : tt;
            const bf16* up = ucat + ((size_t)g * (BATCH * NCHUNK) + b * NCHUNK + t / CH_T) * UCAT_LD + (t % CH_T) * SSM_G;
            float u[16]; float bur = 0.f, bui = 0.f;
#pragma unroll
            for (int c = 0; c < 16; ++c) { u[c] = bf2f(up[c]); bur += bbr[c] * u[c]; bui += bbi[c] * u[c]; }
            const float nsr = abr * sr - abi * si + bur, nsi = abr * si + abi * sr + bui; sr = nsr; si = nsi;
            float mine = 0.f;
#pragma unroll
            for (int c = 0; c < 16; ++c) { const float v = wave_sum(cr[c] * sr - ci[c] * si); if (p == c) mine = v; }
            if (p < 16) {
                const size_t oi = ((size_t)b * SEQ + t) * SSM_W + g * SSM_G + p;
                float up_ = 0.f;
#pragma unroll
                for (int c = 0; c < 16; ++c) if (p == c) up_ = u[c];
                if (dir == 0) ytmp[oi] = mine + d_skip[g * SSM_G + p] * up_;
                else yact[oi] = f2bf(gelu_tanh(ytmp[oi] + mine));
            }
        }
    }
}

struct EP_glu { const bf16* yact; const float* bglu; float* ssm; int row0; int pad;
    __device__ void put(int, int r, int c, float acc) const { const float y = bf2f(yact[(size_t)(row0 + r) * SSM_W + c]); ssm[(size_t)r * SSM_W + c] = y * sigmoidf_(acc + bglu[c]); } };
struct EP_gate_set { const bf16* gate; float* t; int row0; int pad;
    __device__ void put(int, int r, int c, float acc) const { t[(size_t)r * D_MODEL + c] = bf2f(gate[(size_t)(row0 + r) * D_MODEL + c]) * acc; } };
struct EP_gate_add { const bf16* gate; float* t; int row0; int pad;
    __device__ void put(int, int r, int c, float acc) const { t[(size_t)r * D_MODEL + c] += bf2f(gate[(size_t)(row0 + r) * D_MODEL + c]) * acc; } };
struct EP_resid { const float* x; float* out;
    __device__ void put(int, int r, int c, float acc) const { out[(size_t)r * D_MODEL + c] = x[(size_t)r * D_MODEL + c] + acc; } };

struct EP_sigmoid { float* o; int ld; int pad; __device__ void put(int, int r, int c, float acc) const { o[(size_t)r * ld + c] = sigmoidf_(acc); } };
struct EP_store { float* o; int ld; int pad; __device__ void put(int, int r, int c, float acc) const { o[(size_t)r * ld + c] = acc; } };
struct EP_add { float* o; int ld; int pad; __device__ void put(int, int r, int c, float acc) const { o[(size_t)r * ld + c] += acc; } };
struct EP_silu_mul { const float* g; float* o; int ld; int pad; __device__ void put(int, int r, int c, float acc) const { const float gv = g[(size_t)r * ld + c]; o[(size_t)r * ld + c] = gv * sigmoidf_(gv) * acc; } };
struct EP_slot_store { float* o; const int* base; __device__ void put(int z, int r, int c, float acc) const { o[(size_t)(base[z] + r) * EXP_D + c] = acc; } };
struct EP_slot_silu { float* o; const int* base; const float* w; int cap; int pad;
    __device__ void put(int z, int r, int c, float acc) const { float* e = o + (size_t)(base[z] + r) * EXP_D + c; const float gv = *e; *e = gv * sigmoidf_(gv) * acc * w[(size_t)z * cap + r]; } };
struct EP_scatter_add { float* acc_; const int* list; int cap; int pad;
    __device__ void put(int z, int r, int c, float acc) const { atomicAdd(acc_ + (size_t)list[(size_t)z * cap + r] * D_MODEL + c, acc); } };

__global__ void __launch_bounds__(256) k_route(const float* __restrict__ scores, const float* __restrict__ rbias, int* __restrict__ cnt, int* __restrict__ list, float* __restrict__ listw, int rows, int cap) {
    const int t = blockIdx.x * 256 + threadIdx.x;
    if (t >= rows) return;
    float s[64], bsd[64];
#pragma unroll
    for (int e = 0; e < 64; ++e) { s[e] = scores[(size_t)t * 64 + e]; bsd[e] = s[e] + rbias[e]; }
    float gs[8];
#pragma unroll
    for (int g = 0; g < 8; ++g) { float m1 = -INFINITY, m2 = -INFINITY;
#pragma unroll
        for (int j = 0; j < 8; ++j) { const float v = bsd[g * 8 + j]; if (v > m1) { m2 = m1; m1 = v; } else if (v > m2) m2 = v; }
        gs[g] = m1 + m2; }
    unsigned gmask = 0;
#pragma unroll
    for (int k = 0; k < TOPK_G; ++k) { int best = -1; float bv = -INFINITY;
#pragma unroll
        for (int g = 0; g < 8; ++g) if (!((gmask >> g) & 1u) && gs[g] > bv) { bv = gs[g]; best = g; }
        gmask |= 1u << best; }
    unsigned long long emask = 0ull; int idx[8]; float wsum = 0.f;
#pragma unroll
    for (int k = 0; k < TOP_K; ++k) { int best = -1; float bv = -INFINITY;
#pragma unroll
        for (int e = 0; e < 64; ++e) { const bool ok = ((gmask >> (e >> 3)) & 1u) && !((emask >> e) & 1ull); if (ok && bsd[e] > bv) { bv = bsd[e]; best = e; } }
        emask |= 1ull << best; idx[k] = best; }
#pragma unroll
    for (int k = 0; k < 8; ++k) { float sv = 0.f;
#pragma unroll
        for (int e = 0; e < 64; ++e) if (e == idx[k]) sv = s[e];
        wsum += sv; }
#pragma unroll
    for (int k = 0; k < 8; ++k) { float sv = 0.f;
#pragma unroll
        for (int e = 0; e < 64; ++e) if (e == idx[k]) sv = s[e];
        const int e = idx[k]; const int pos = atomicAdd(cnt + e, 1);
        list[(size_t)e * cap + pos] = t; listw[(size_t)e * cap + pos] = sv / wsum * ROUTED_SCALE; }
}
__global__ void k_prefix(const int* __restrict__ cnt, int* __restrict__ base) { if (threadIdx.x == 0) { int s = 0; for (int e = 0; e < 64; ++e) { base[e] = s; s += cnt[e]; } } }

struct EP_ple { float* h; const float* pp;
    __device__ void put(int, int r, int c, float acc) const { float* e = h + (size_t)r * D_MODEL + c; *e = *e + sigmoidf_(acc) * pp[(size_t)r * D_MODEL + c]; } };
__global__ void __launch_bounds__(256) k_final(float* __restrict__ h, const float* __restrict__ g, int rows) {
    const int row = blockIdx.x * 4 + (threadIdx.x >> 6), lane = threadIdx.x & 63;
    if (row >= rows) return;
    float4* hr = (float4*)(h + (size_t)row * D_MODEL);
    float4 v[4]; float s = 0.f;
#pragma unroll
    for (int j = 0; j < 4; ++j) { v[j] = hr[lane + 64 * j]; s += v[j].x * v[j].x + v[j].y * v[j].y + v[j].z * v[j].z + v[j].w * v[j].w; }
    const float r = rsqrtf(wave_sum(s) * (1.f / D_MODEL) + EPS);
#pragma unroll
    for (int j = 0; j < 4; ++j) { const float4 gg = ((const float4*)g)[lane + 64 * j]; hr[lane + 64 * j] = make_float4(v[j].x * r * gg.x, v[j].y * r * gg.y, v[j].z * r * gg.z, v[j].w * r * gg.w); }
}

__global__ void __launch_bounds__(256) k_naive_winT(const float* __restrict__ w, const float* __restrict__ g, bf16* __restrict__ wt) {
    const size_t idx = (size_t)blockIdx.x * 256 + threadIdx.x;
    if (idx >= (size_t)IN_W * D_MODEL) return;
    const int n = (int)(idx / D_MODEL), k = (int)(idx % D_MODEL);
    wt[(size_t)inproj_phys(n) * D_MODEL + k] = f2bf(w[(size_t)k * IN_W + n] * g[k]);
}
__global__ void __launch_bounds__(256) k_naive_xb(const float* __restrict__ x, bf16* __restrict__ xb) {
    const size_t idx = (size_t)blockIdx.x * 256 + threadIdx.x;
    if (idx < (size_t)NTOK * D_MODEL) xb[idx] = f2bf(x[idx]);
}
__global__ void __launch_bounds__(256) k_naive_rope(float* __restrict__ rope) {
    const int e = blockIdx.x * 256 + threadIdx.x; if (e >= 1024) return;
    const int coord = e >> 4, i = e & 15; const float invf = powf(10000.f, -(float)(2 * i) / 32.f);
    rope[2 * e] = cosf((float)coord * invf); rope[2 * e + 1] = sinf((float)coord * invf);
}
__global__ void __launch_bounds__(256) k_dbg_cmp(const unsigned* __restrict__ a, const unsigned* __restrict__ b, size_t nwords, unsigned* __restrict__ cnt) {
    size_t i = (size_t)blockIdx.x * 256 + threadIdx.x; unsigned bad = 0;
    for (; i < nwords; i += (size_t)gridDim.x * 256) bad += (a[i] != b[i]) ? 1u : 0u;
    if (bad) atomicAdd(cnt, bad);
}
__global__ void k_dbg_flag(const unsigned* __restrict__ cnt, float* __restrict__ out) { if (threadIdx.x == 0 && blockIdx.x == 0 && cnt[0] != 0u) out[0] = __builtin_nanf(""); }
__global__ void __launch_bounds__(256) k_dbg_sum(const unsigned* __restrict__ a, size_t nwords, unsigned* __restrict__ acc2) {
    size_t i = (size_t)blockIdx.x * 256 + threadIdx.x; unsigned s0 = 0, s1 = 0;
    for (; i < nwords; i += (size_t)gridDim.x * 256) { const unsigned w = a[i]; s0 += w; s1 += w * (unsigned)(i * 2654435761u + 12345u); }
    atomicAdd(acc2, s0); atomicAdd(acc2 + 1, s1);
}
__global__ void k_dbg_check(unsigned* __restrict__ rec) {
    if (threadIdx.x != 0 || blockIdx.x != 0) return;
    unsigned flag = 0;
    if (rec[16] == 0x1234abcdu) { for (int b = 0; b < 6; ++b) if (rec[17 + 2 * b] != rec[2 * b] || rec[18 + 2 * b] != rec[2 * b + 1]) flag |= 1u << b; }
    for (int i = 0; i < 12; ++i) rec[17 + i] = rec[i];
    rec[16] = 0x1234abcdu; rec[32] = flag;
}
__global__ void __launch_bounds__(256) k_dbg_zero(const unsigned* __restrict__ rec, float* __restrict__ out) {
    const unsigned flag = rec[32]; if (!flag) return;
    int b = 0; while (!((flag >> b) & 1u)) ++b;
    const float fr = (float)(b + 1) / 8.f; const size_t n = (size_t)((double)NTOK * D_MODEL * (double)(fr * fr));
    for (size_t i = (size_t)blockIdx.x * 256 + threadIdx.x; i < n; i += (size_t)gridDim.x * 256) out[i] = 0.f;
}
static int g_grid = 0;
static void launch_mk(hipStream_t stream, void* const* d_in, void* d_out, void* d_ws, int lo, int hi, int li, int grid_override = 0) {
    Args a{};
    for (int i = 0; i < 32; ++i) a.in[i] = (const float*)d_in[i];
    a.out = (float*)d_out; a.ws = (unsigned char*)d_ws; a.ph_lo = lo; a.ph_hi = hi; a.li = li; a.pad = 0;
    hipLaunchKernelGGL(mk_fwd, dim3(grid_override ? grid_override : g_grid), dim3(NWAVES * 64), 0, stream, a);
    const hipError_t le = hipPeekAtLastError();
    if (le != hipSuccess) fprintf(stderr, "kernel_launch: mk_fwd launch failed: %s\n", hipGetErrorName(le));
}
extern "C" void kernel_launch(void* const* d_in, const int* in_sizes, int n_in, void* d_out, int out_size, void* d_ws, size_t ws_size, hipStream_t stream) {
    (void)in_sizes; (void)n_in; (void)out_size;
    if (ws_size < 1024 * MiB) { fprintf(stderr, "kernel_launch: workspace too small (%zu)\n", ws_size); return; }
    if (g_grid == 0) {
        int dev = 0, cus = 0, per_cu = 0;
        if (hipGetDevice(&dev) != hipSuccess || hipDeviceGetAttribute(&cus, hipDeviceAttributeMultiprocessorCount, dev) != hipSuccess) { fprintf(stderr, "kernel_launch: device query failed\n"); g_grid = -1; return; }

        if (hipOccupancyMaxActiveBlocksPerMultiprocessor(&per_cu, (const void*)mk_fwd, NWAVES * 64, 0) != hipSuccess || per_cu < 1) fprintf(stderr, "kernel_launch: occupancy query reports %d\n", per_cu);
        (void)hipGetLastError();
        g_grid = cus;
    }
    if (g_grid < 0) return;
    (void)hipMemsetAsync((char*)d_ws + WS_CTL, 0, 1 * MiB, stream);
    const float* x = (const float*)d_in[0]; const float* p = (const float*)d_in[1];
    const float* w_attn_up = (const float*)d_in[6];
    const float* a_re = (const float*)d_in[7]; const float* a_im = (const float*)d_in[8]; const float* log_dt = (const float*)d_in[9];
    const float* b_re = (const float*)d_in[10]; const float* b_im = (const float*)d_in[11]; const float* c_re = (const float*)d_in[12]; const float* c_im = (const float*)d_in[13];
    const float* d_skip = (const float*)d_in[14]; const float* w_glu = (const float*)d_in[15]; const float* b_glu = (const float*)d_in[16]; const float* w_ssm_up = (const float*)d_in[17];
    const float* w_out = (const float*)d_in[18]; const float* g_ffn = (const float*)d_in[19]; const float* w_router = (const float*)d_in[20]; const float* router_bias = (const float*)d_in[21];
    const float* w_exp_gate = (const float*)d_in[22]; const float* w_exp_up = (const float*)d_in[23]; const float* w_exp_down = (const float*)d_in[24];
    const float* w_sh_gate = (const float*)d_in[25]; const float* w_sh_up = (const float*)d_in[26]; const float* w_sh_down = (const float*)d_in[27];
    const float* g_ple = (const float*)d_in[28]; const float* w_ple_gate = (const float*)d_in[29]; const float* w_ple_proj = (const float*)d_in[30]; const float* g_final = (const float*)d_in[31];
    float* out = (float*)d_out; char* ws = (char*)d_ws;
    bf16* Qb = (bf16*)(ws + WS_Q); bf16* Ob = (bf16*)(ws + WS_O); bf16* Kb = (bf16*)(ws + WS_K); bf16* Vb = (bf16*)(ws + WS_V);
    bf16* ucat = (bf16*)(ws + WS_UCAT); bf16* GA = (bf16*)(ws + WS_GA); bf16* GS = (bf16*)(ws + WS_GS); bf16* yact = (bf16*)(ws + WS_YACT); bf16* xn3 = (bf16*)(ws + WS_XN3);
    char* tmp = ws + WS_TMP;

    launch_mk(stream, d_in, d_out, d_ws, 0, PH_END, 0);
    (void)x; (void)p; (void)w_attn_up; (void)a_re; (void)a_im; (void)log_dt; (void)b_re; (void)b_im; (void)c_re; (void)c_im; (void)d_skip; (void)w_glu; (void)b_glu; (void)w_ssm_up; (void)w_out;
    (void)g_ffn; (void)w_router; (void)router_bias; (void)w_exp_gate; (void)w_exp_up; (void)w_exp_down; (void)w_sh_gate; (void)w_sh_up; (void)w_sh_down; (void)g_ple; (void)w_ple_gate; (void)w_ple_proj; (void)g_final;
    (void)out; (void)Qb; (void)Ob; (void)Kb; (void)Vb; (void)ucat; (void)GA; (void)GS; (void)yact; (void)xn3; (void)tmp;
}
```

```cpp
#include <hip/hip_runtime.h>
#include <cstdio>
#include <cstdint>
#include <cmath>

constexpr int D_MODEL = 1024, BATCH = 32, SEQ = 2048, NTOK = BATCH * SEQ;
constexpr int N_HEADS = 8, N_KV = 2, HD = 64, Q_W = 512, KV_W = 128;
constexpr int SSM_W = 256, SSM_G = 16, SSM_NG = 16, SSM_P = 64;
constexpr int N_EXP = 64, EXP_D = 128, TOP_K = 8, N_EG = 8, TOPK_G = 4, EPG = 8, SH_D = 256;
constexpr int PLE_D = 256, IN_W = 3072;
constexpr float EPS = 1e-6f, ROUTED_SCALE = 2.5f;
constexpr float C2 = 0.125f * 1.4426950408889634f;
constexpr int CH_T = 64, NCHUNK = SEQ / CH_T;
constexpr int UCAT_LD = CH_T * SSM_G + 256;

#define GAS __attribute__((address_space(1)))
#define LAS __attribute__((address_space(3)))
typedef unsigned short bf16;
typedef unsigned v4u __attribute__((ext_vector_type(4)));
typedef unsigned v2u __attribute__((ext_vector_type(2)));
typedef float f32x4 __attribute__((ext_vector_type(4)));
typedef float f32x2 __attribute__((ext_vector_type(2)));
typedef short bf16x8 __attribute__((ext_vector_type(8)));
typedef GAS unsigned gu32;
#define RLX_AGENT __ATOMIC_RELAXED, __HIP_MEMORY_SCOPE_AGENT
#define LDS_WAIT() asm volatile("s_waitcnt lgkmcnt(0)" ::: "memory")
#define VM_WAIT() asm volatile("s_waitcnt vmcnt(0)" ::: "memory")
__device__ __forceinline__ bf16 f2bf(float f) { unsigned u = __builtin_bit_cast(unsigned, f); return (bf16)((u + 0x7fffu + ((u >> 16) & 1u)) >> 16); }
__device__ __forceinline__ float bf2f(bf16 h) { return __builtin_bit_cast(float, (unsigned)h << 16); }
__device__ __forceinline__ unsigned pk2(float lo, float hi) { return (unsigned)f2bf(lo) | ((unsigned)f2bf(hi) << 16); }
typedef __bf16 bf16x2_t __attribute__((ext_vector_type(2)));
__device__ __forceinline__ unsigned cvt_pk_bf16(float lo, float hi) { f32x2 v = {lo, hi}; bf16x2_t b = __builtin_convertvector(v, bf16x2_t); return __builtin_bit_cast(unsigned, b); }
__device__ __forceinline__ float sigmoidf_(float x) { return 1.f / (1.f + __expf(-x)); }
__device__ __forceinline__ float fsig(float x) { return __builtin_amdgcn_rcpf(1.f + __builtin_amdgcn_exp2f(-1.4426950408889634f * x)); }
__device__ __forceinline__ float gelu_tanh(float x) { const float u = 0.7978845608028654f * (x + 0.044715f * x * x * x); return 0.5f * x * (1.f + tanhf(u)); }
__device__ __forceinline__ float wave_sum(float v) {
#pragma unroll
    for (int o = 1; o < 64; o <<= 1) v += __shfl_xor(v, o);
    return v;
}

constexpr size_t MiB = 1u << 20;
constexpr size_t WS_CTL = 0;
constexpr size_t WS_RSTD1 = 1 * MiB;
constexpr size_t WS_RSTD2 = WS_RSTD1 + 256 * 1024;
constexpr size_t WS_ROPE = WS_RSTD2 + 256 * 1024;
constexpr size_t WS_IDENT = WS_ROPE + 256 * 1024;
constexpr size_t WS_WIN = 2 * MiB;
constexpr size_t WS_WAU = WS_WIN + 6 * MiB;
constexpr size_t WS_WSU = WS_WAU + 1 * MiB;
constexpr size_t WS_WGLU = WS_WSU + 512 * 1024;
constexpr size_t WS_WOUT = WS_WGLU + 512 * 1024;
constexpr size_t WS_WEGU = WS_WOUT + 2 * MiB;
constexpr size_t WS_WED = WS_WEGU + 32 * MiB;
constexpr size_t WS_WSGU = WS_WED + 16 * MiB;
constexpr size_t WS_WSD = WS_WSGU + 1 * MiB;
constexpr size_t WS_WPG = WS_WSD + 512 * 1024;
constexpr size_t WS_WPP = WS_WPG + 2 * MiB;
constexpr size_t WS_BTCAT = WS_WPP + 512 * 1024;
constexpr size_t WS_BTST = WS_BTCAT + 40 * MiB;
constexpr size_t WS_WROUTER = WS_BTST + 8 * MiB;
constexpr size_t WS_WEND = WS_WROUTER + 512 * 1024;
static_assert(WS_WEND <= 114 * MiB, "weights region");
constexpr size_t WS_Q = 114 * MiB;
constexpr size_t WS_O = WS_Q + 64 * MiB;
constexpr size_t WS_K = WS_O + 64 * MiB;
constexpr size_t WS_V = WS_K + 16 * MiB;
constexpr size_t WS_UCAT = WS_V + 16 * MiB;
constexpr size_t WS_GA = WS_UCAT + 40 * MiB;
constexpr size_t WS_GS = WS_GA + 128 * MiB;
constexpr size_t WS_YACT = WS_GS + 128 * MiB;
constexpr size_t WS_XB = WS_YACT + 32 * MiB;
constexpr size_t WS_TMP = WS_XB + 128 * MiB;
constexpr size_t WS_TMP_BYTES = 1024 * MiB - WS_TMP;
static_assert(WS_TMP_BYTES >= 240 * MiB, "naive temporaries");
constexpr size_t WS_LST = WS_TMP;

constexpr size_t WS_XN2 = 114 * MiB;
constexpr size_t WS_XN3 = WS_XN2;
constexpr size_t WS_HID = WS_XN2 + 128 * MiB;
constexpr size_t WS_HSH = WS_HID + 132 * MiB;
constexpr size_t WS_LTOK = WS_HSH + 32 * MiB;
constexpr size_t WS_LW = WS_LTOK + 16 * MiB;
constexpr size_t WS_LROW = WS_LW + 16 * MiB;
constexpr size_t WS_LOGIT = WS_LROW + 16 * MiB;
constexpr size_t WS_YSLOT = WS_LOGIT + 32 * MiB;
static_assert(WS_YSLOT + 528 * MiB <= 1024 * MiB, "workspace");
namespace pg8 {
#define PG8_LAS __attribute__((address_space(3)))
typedef unsigned short bf16_t;
typedef unsigned u32x4 __attribute__((ext_vector_type(4)));
constexpr int BM = 256, BK = 64, HALF = 128, HTB = HALF * BK * 2  , STAGE_BYTES = 8 * HTB, NXCD = 8, WGM = 8;
__host__ __device__ __forceinline__ int lds_byte(int r, int c) { const int st = (r >> 4) * 2 + (c >> 5), rr = r & 15, cc = c & 31, ob = rr * 64 + cc * 2; return st * 1024 + (ob ^ (((ob >> 9) & 1) << 5)); }
__host__ __device__ __forceinline__ void stage_rc(int b, int& R, int& C) { const int st = b / 1024, sb = b % 1024, swz = sb ^ (((sb >> 9) & 1) << 5); R = (st >> 1) * 16 + swz / 64; C = (st & 1) * 32 + (swz % 64) / 2; }
__host__ __device__ __forceinline__ int perm32(int rho) { const int n = rho >> 4, i = rho & 15; return 8 * (i >> 2) + 4 * n + (i & 3); }

struct Unit { int pm, pn; const char* A; const char* B; const int* rows; int nrows; int aux; };
struct Desc { int K; unsigned lda2, ldb2; };
struct NoPre {};
#define PG8_NO_PREFETCH using Pre = pg8::NoPre; __device__ __forceinline__ void prefetch(Pre&, const pg8::Unit&, int, int) const {}

__device__ __forceinline__ bool static_tile(int nM, int nN, int G, int c, int i, int& pm, int& pn) {
    const int nwg = nM * nN; const long L = (long)i * G + c; if (L >= nwg) return false;
    int wgid = (int)L; { const int q = nwg / NXCD, r = nwg % NXCD, xcd = wgid % NXCD, off = wgid / NXCD; wgid = (xcd < r ? xcd * (q + 1) : r * (q + 1) + (xcd - r) * q) + off; }
    const int nig = WGM * nN, gid = wgid / nig, fm = gid * WGM, gsz = (nM - fm) < WGM ? (nM - fm) : WGM;
    pm = fm + ((wgid % nig) % gsz); pn = (wgid % nig) / gsz; return true;
}
struct PlainOrder {
    const char* A; const char* B; int nM, nN, G, c; unsigned lda2, ldb2;
    __device__ __forceinline__ bool next(int i, Unit& u) const {
        if (!static_tile(nM, nN, G, c, i, u.pm, u.pn)) return false;
        u.A = A + (size_t)u.pm * BM * lda2; u.B = B + (size_t)u.pn * BM * ldb2; u.rows = nullptr; u.nrows = BM; u.aux = 0; return true; }
};

template <class Epi, class Sched, bool ALIGN_EPI, bool GATHER>
__device__ __forceinline__ void gemm_run(PG8_LAS unsigned char* lds, const Desc g, const Sched& S, const Epi& E) {
    int tid = threadIdx.x; asm volatile("" : "+v"(tid));
    const int wid = __builtin_amdgcn_readfirstlane(tid >> 6), lane = tid & 63, wr = wid >> 2, wc = wid & 3, fr = lane & 15, fq = lane >> 4;
    const int nt = g.K / BK;
    int R[2], C[2]; unsigned voffB[2], voffA[2][2], nvoffA[2][2];
#pragma unroll
    for (int i = 0; i < 2; ++i) { stage_rc(tid * 16 + i * 8192, R[i], C[i]); const int Rb = Epi::PERM ? ((R[i] & ~31) + perm32(R[i] & 31)) : R[i];
        voffB[i] = (unsigned)Rb * g.ldb2 + (unsigned)C[i] * 2u; }
    const size_t kstep = (size_t)(BK * 2);
    const size_t hstepB = (size_t)HALF * g.ldb2;
    const unsigned ldsw = (unsigned)wid * 1024u;
    const int aoff = lds_byte(wr * 64 + fr, fq * 8), boff = lds_byte(wc * 32 + fr, fq * 8);
    unsigned bbv[2][2];
#pragma unroll
    for (int b = 0; b < 2; ++b)
#pragma unroll
        for (int h = 0; h < 2; ++h) { bbv[b][h] = (unsigned)(boff + (4 + b * 2 + h) * HTB); asm volatile("" : "+v"(bbv[b][h])); }
#define PG8_SA(b, h) (((b) * 2 + (h)) * HTB)
#define PG8_SB(b, h) ((4 + (b) * 2 + (h)) * HTB)
#define PG8_STAGE(bufoff, gbase, voff) do { _Pragma("unroll") for (int _i = 0; _i < 2; ++_i) \
        __builtin_amdgcn_global_load_lds((const unsigned*)((const char*)(gbase) + (voff)[_i]), (PG8_LAS unsigned*)(lds + (bufoff) + ldsw + _i * 8192), 16, 0, 0); } while (0)
#define PG8_LDA(dst, b, h) do { _Pragma("unroll") for (int m = 0; m < 4; ++m) _Pragma("unroll") for (int k = 0; k < 2; ++k) dst[m][k] = *(const PG8_LAS bf16x8*)(lds + PG8_SA(b, h) + aoff + m * 2048 + k * 1024); } while (0)
#define PG8_LDB(dst, b, h) do { _Pragma("unroll") for (int n = 0; n < 2; ++n) _Pragma("unroll") for (int k = 0; k < 2; ++k) dst[n][k] = *(const PG8_LAS bf16x8*)(lds + bbv[b][h] + n * 2048 + k * 1024); } while (0)
#define PG8_MMA(ai, bj, At, Bt) do { __builtin_amdgcn_s_setprio(1); _Pragma("unroll") for (int m = 0; m < 4; ++m) _Pragma("unroll") for (int n = 0; n < 2; ++n) _Pragma("unroll") for (int k = 0; k < 2; ++k) \
        acc[ai][bj][m][n] = __builtin_amdgcn_mfma_f32_16x16x32_bf16(Bt[n][k], At[m][k], acc[ai][bj][m][n], 0, 0, 0); __builtin_amdgcn_s_setprio(0); } while (0)
#define PG8_WAIT_V(n) asm volatile("s_waitcnt vmcnt(" #n ")" ::: "memory")
#define PG8_WAIT_L(n) asm volatile("s_waitcnt lgkmcnt(" #n ")" ::: "memory")
#define PG8_BAR __builtin_amdgcn_s_barrier()
#define PG8_SCHED __builtin_amdgcn_sched_barrier(0)
#define PG8_SETVA(dst, un) do { _Pragma("unroll") for (int h = 0; h < 2; ++h) _Pragma("unroll") for (int i = 0; i < 2; ++i) { \
        if constexpr (GATHER) { int rr = h * HALF + R[i]; rr = rr < (un).nrows ? rr : (un).nrows - 1; dst[h][i] = (unsigned)(un).rows[rr] * g.lda2 + (unsigned)C[i] * 2u; } \
        else dst[h][i] = (unsigned)(h * HALF + R[i]) * g.lda2 + (unsigned)C[i] * 2u; } } while (0)
    Unit cur, nxt; int ui = 0;
    if (!S.next(0, cur)) return;
    PG8_SETVA(voffA, cur);
    typename Epi::Pre pre; E.prefetch(pre, cur, wr, fr);
    f32x4 acc[2][2][4][2];
#pragma unroll
    for (int a = 0; a < 2; ++a)
#pragma unroll
        for (int b = 0; b < 2; ++b)
#pragma unroll
            for (int m = 0; m < 4; ++m)
#pragma unroll
                for (int n = 0; n < 2; ++n) acc[a][b][m][n] = (f32x4){0.f, 0.f, 0.f, 0.f};
    bf16x8 At[4][2], B0[2][2], B1[2][2];
    const char* cA = cur.A; const char* cB = cur.B;
    PG8_STAGE(PG8_SB(0, 0), cB, voffB); PG8_STAGE(PG8_SB(0, 1), cB + hstepB, voffB); PG8_STAGE(PG8_SA(0, 0), cA, voffA[0]); PG8_STAGE(PG8_SA(0, 1), cA, voffA[1]);
    if (wr == 1) PG8_BAR;
    PG8_WAIT_V(2); PG8_BAR;
    PG8_STAGE(PG8_SB(1, 0), cB + kstep, voffB); PG8_STAGE(PG8_SA(1, 0), cA + kstep, voffA[0]); PG8_STAGE(PG8_SB(1, 1), cB + hstepB + kstep, voffB);
    PG8_WAIT_V(6); PG8_BAR;
    for (;;) {
        const bool has_next = S.next(ui + 1, nxt);
        const char* nA = has_next ? nxt.A : cA; const char* nB = has_next ? nxt.B : cB;
        if constexpr (GATHER) { if (has_next) { PG8_SETVA(nvoffA, nxt); } else {
#pragma unroll
            for (int h = 0; h < 2; ++h)
#pragma unroll
                for (int i = 0; i < 2; ++i) nvoffA[h][i] = voffA[h][i]; } }
#pragma nounroll
        for (int t = 0; t < nt; t += 2) {
            const bool last = (t == nt - 2);
            const char* a1 = cA + (size_t)(t + 1) * kstep;
            const char* a2 = last ? nA : cA + (size_t)(t + 2) * kstep; const char* b2 = last ? nB : cB + (size_t)(t + 2) * kstep;
            const char* a3 = a2 + kstep; const char* b3 = b2 + kstep;
            unsigned v2[2][2];
#pragma unroll
            for (int h = 0; h < 2; ++h)
#pragma unroll
                for (int i = 0; i < 2; ++i) { if constexpr (GATHER) v2[h][i] = last ? nvoffA[h][i] : voffA[h][i]; else v2[h][i] = voffA[h][i]; }
            PG8_LDB(B0, 0, 0); PG8_LDB(B1, 0, 1); PG8_SCHED; PG8_LDA(At, 0, 0); PG8_STAGE(PG8_SA(1, 1), a1, voffA[1]);
            PG8_WAIT_V(8); PG8_WAIT_L(0); PG8_BAR; PG8_MMA(0, 0, At, B0); PG8_MMA(0, 1, At, B1); PG8_BAR; PG8_SCHED;
            PG8_LDA(At, 0, 1); PG8_STAGE(PG8_SB(0, 0), b2, voffB); PG8_STAGE(PG8_SB(0, 1), b2 + hstepB, voffB); PG8_STAGE(PG8_SA(0, 0), a2, v2[0]);
            PG8_WAIT_V(8); PG8_WAIT_L(0); PG8_BAR; PG8_MMA(1, 0, At, B0); PG8_MMA(1, 1, At, B1); PG8_BAR; PG8_SCHED;
            PG8_LDB(B0, 1, 0); PG8_LDB(B1, 1, 1); PG8_SCHED; PG8_LDA(At, 1, 0); PG8_STAGE(PG8_SA(0, 1), a2, v2[1]);
            PG8_WAIT_V(8); PG8_WAIT_L(0); PG8_BAR; PG8_MMA(0, 0, At, B0); PG8_MMA(0, 1, At, B1); PG8_BAR; PG8_SCHED;
            PG8_LDA(At, 1, 1); PG8_STAGE(PG8_SB(1, 0), b3, voffB); PG8_STAGE(PG8_SB(1, 1), b3 + hstepB, voffB); PG8_STAGE(PG8_SA(1, 0), a3, v2[0]);
            PG8_WAIT_V(8); PG8_WAIT_L(0); PG8_BAR; PG8_MMA(1, 0, At, B0); PG8_MMA(1, 1, At, B1); PG8_BAR; PG8_SCHED;
        }
        if constexpr (ALIGN_EPI) { if (wr == 0) PG8_BAR; }
        { int fr2 = fr, fq2 = fq; asm volatile("" : "+v"(fr2), "+v"(fq2));
          E(acc, cur, wr, wc, fr2, fq2, pre); }
        if (!has_next) break;
#pragma unroll
        for (int a = 0; a < 2; ++a)
#pragma unroll
            for (int b = 0; b < 2; ++b)
#pragma unroll
                for (int m = 0; m < 4; ++m)
#pragma unroll
                    for (int n = 0; n < 2; ++n) acc[a][b][m][n] = (f32x4){0.f, 0.f, 0.f, 0.f};
        cur = nxt; cA = nA; cB = nB; ++ui;
        E.prefetch(pre, cur, wr, fr);
        if constexpr (GATHER) {
#pragma unroll
            for (int h = 0; h < 2; ++h)
#pragma unroll
                for (int i = 0; i < 2; ++i) voffA[h][i] = nvoffA[h][i]; }
        if constexpr (ALIGN_EPI) { if (wr == 1) PG8_BAR; }
    }
    PG8_WAIT_V(0);
    if constexpr (!ALIGN_EPI) { if (wr == 0) PG8_BAR; }
    PG8_BAR;
#undef PG8_SA
#undef PG8_SB
#undef PG8_STAGE
#undef PG8_LDA
#undef PG8_LDB
#undef PG8_MMA
#undef PG8_WAIT_V
#undef PG8_WAIT_L
#undef PG8_BAR
#undef PG8_SCHED
#undef PG8_SETVA
}
}
#define XB_TMO      128
#define XB_XCNT(j)  (256  + 64 * (j))
#define XB_XSUB(j)  (1280 + 64 * (j))
#define XB_XGEN(j)  (2304 + 64 * (j))
#define XB_TOP      3328
#define XB_TOPGEN   3392
#define XCD_BAR_WORDS 3456
#define XB_SPIN_CAP (1u << 18)

__device__ __forceinline__ unsigned xb_ld(unsigned* p)              { return __hip_atomic_load(p, __ATOMIC_RELAXED, __HIP_MEMORY_SCOPE_AGENT); }
__device__ __forceinline__ unsigned xb_add(unsigned* p, unsigned v) { return __hip_atomic_fetch_add(p, v, __ATOMIC_RELAXED, __HIP_MEMORY_SCOPE_AGENT); }
__device__ __forceinline__ unsigned xb_xcc_id() { return (unsigned)__builtin_amdgcn_s_getreg((3 << 11) | 20) & 0xFu; }
#define XB_SPIN(cond, bar) do { unsigned _sp = 0; while (cond) { __builtin_amdgcn_s_sleep(1); \
    if ((++_sp & 255u) == 0u) { if (xb_ld(&(bar)[XB_TMO])) break; if (_sp > XB_SPIN_CAP) { atomicAdd(&(bar)[XB_TMO], 1u); break; } } } } while (0)

struct XcdBarrier {
    unsigned* bar; unsigned x;
    volatile LAS unsigned* st;
};

__device__ __forceinline__ XcdBarrier xcd_barrier_post(unsigned* bar, volatile LAS unsigned* st) {
    XcdBarrier b; b.bar = bar; b.x = xb_xcc_id(); b.st = st;
    if (threadIdx.x == 0) (void)xb_add(&bar[XB_XCNT(b.x)], 1u);
    return b;
}
__device__ __forceinline__ void xcd_barrier_complete(unsigned* bar, unsigned x, unsigned& nloc, unsigned& nx) {
    const unsigned G = gridDim.x * gridDim.y * gridDim.z;
    unsigned sum, cnt, mine, sp = 0u;
    for (;;) {
        sum = 0u; cnt = 0u; mine = 0u;
#pragma unroll
        for (unsigned j = 0; j < 16; ++j) { const unsigned c = xb_ld(&bar[XB_XCNT(j)]); sum += c; cnt += (c > 0u) ? 1u : 0u; mine = (j == x) ? c : mine; }
        if (sum == G) break;
        __builtin_amdgcn_s_sleep(1);
        if ((++sp & 255u) == 0u) { if (xb_ld(&bar[XB_TMO])) break; if (sp > XB_SPIN_CAP) { atomicAdd(&bar[XB_TMO], 1u); break; } }
    }
    nloc = mine > 0u ? mine : 1u; nx = cnt > 0u ? cnt : 1u;
}

__device__ __forceinline__ void xcd_barrier(const XcdBarrier& b) {
    asm volatile("s_waitcnt vmcnt(0)" ::: "memory");
    __syncthreads();
    if (threadIdx.x == 0) {
        unsigned* bar = b.bar;
        __builtin_amdgcn_s_waitcnt(0);
        unsigned nloc = b.st[0], nx = b.st[1];
        if (nloc == 0u) { xcd_barrier_complete(bar, b.x, nloc, nx); b.st[0] = nloc; b.st[1] = nx; }
        const unsigned old = xb_add(&bar[XB_XSUB(b.x)], 1u);
        const unsigned gen = old / nloc;
        if (old + 1u == (gen + 1u) * nloc) {
            __builtin_amdgcn_fence(__ATOMIC_RELEASE, "agent");
            asm volatile("s_waitcnt vmcnt(0)" ::: "memory");
            const unsigned og = xb_add(&bar[XB_TOP], 1u);
            const unsigned tg = og / nx;
            if (og + 1u == (tg + 1u) * nx) xb_add(&bar[XB_TOPGEN], 1u);
            else XB_SPIN(xb_ld(&bar[XB_TOPGEN]) == tg, bar);
            __builtin_amdgcn_fence(__ATOMIC_ACQUIRE, "agent");
            xb_add(&bar[XB_XGEN(b.x)], 1u);
            asm volatile("s_waitcnt vmcnt(0)" ::: "memory");
        } else {
            XB_SPIN(xb_ld(&bar[XB_XGEN(b.x)]) == gen, bar);
            __builtin_amdgcn_fence(__ATOMIC_ACQUIRE, "agent");
            asm volatile("s_waitcnt vmcnt(0)" ::: "memory");
        }
    }
    __syncthreads();
}
constexpr int NWAVES = 8;
constexpr int RING_OFF = 0, RING_BYTES = 131072;
constexpr int LDSCTL_OFF = RING_BYTES, MISC_OFF = LDSCTL_OFF + 320;
constexpr int LDS_BYTES = 147456;
constexpr int LDS_ROPE_OFF = LDSCTL_OFF + 4096;
static_assert(LDS_ROPE_OFF + 8192 <= LDS_BYTES, "LDS map");
constexpr int CW_TMO = 0, CW_CODE = 1, CW_CNT = 2048, CW_BAR = 4096;
constexpr int N_BAR_REGIONS = 8;
static_assert((CW_BAR + N_BAR_REGIONS * XCD_BAR_WORDS) * 4 <= (int)(1 * MiB), "CTL words inside the memset region");

struct Args { const float* in[32]; float* out; unsigned char* ws; int ph_lo, ph_hi, li, pad; };

__host__ __device__ __forceinline__ int inproj_phys(int L) {
    if (L >= 768) return L; const int o = L & 255, d = o & 63; return (L - o) + 128 * (d >> 5) + 32 * (o >> 6) + (d & 31); }

__device__ __forceinline__ void p0_transpose_item(const float* W, int K, int N, const float* gain, bf16* WT, int ldt, int row_off, int mode, LAS float* scr, int item, int lane) {
    const int nblk = N / 32, kb = item / nblk, nb = item % nblk, k0 = 64 * kb, n0 = 32 * nb;
#pragma unroll 8
    for (int i = 0; i < 32; ++i) { const int kk = 2 * i + (lane >> 5); float v = W[(size_t)(k0 + kk) * N + n0 + (lane & 31)]; if (gain) v *= gain[k0 + kk]; scr[kk * 33 + (lane & 31)] = v; }
    LDS_WAIT(); asm volatile("" ::: "memory");
    const int c = lane & 7;
#pragma unroll
    for (int j = 0; j < 4; ++j) { const int n = (lane >> 3) + 8 * j; const LAS float* s = scr + (8 * c) * 33 + n;
        v4u o; o.x = pk2(s[0 * 33], s[1 * 33]); o.y = pk2(s[2 * 33], s[3 * 33]); o.z = pk2(s[4 * 33], s[5 * 33]); o.w = pk2(s[6 * 33], s[7 * 33]);
        const int nn = n0 + n; const int row = mode == 1 ? inproj_phys(nn) : (mode == 2 ? ((nn >> 7) << 8) + (nn & 127) + row_off : row_off + nn);
        *(GAS v4u*)(WT + (size_t)row * ldt + k0 + 8 * c) = o; }
    LDS_WAIT(); asm volatile("" ::: "memory");
}
struct TrJob { const float* W; const float* gain; bf16* WT; int K, N, ldt, row_off, mode, nmat, rows_per_mat; };
constexpr int N_TRJOBS = 13;
__device__ __forceinline__ TrJob p0_job(const Args& a, int j) {
    unsigned char* ws = a.ws; TrJob t{};
    switch (j) {
    case 0:  t = TrJob{a.in[3],  a.in[2],  (bf16*)(ws + WS_WIN),  D_MODEL, IN_W,    D_MODEL, 0,   1, 1,     0}; break;
    case 1:  t = TrJob{a.in[6],  nullptr,  (bf16*)(ws + WS_WAU),  Q_W,     D_MODEL, Q_W,     0,   0, 1,     0}; break;
    case 2:  t = TrJob{a.in[17], nullptr,  (bf16*)(ws + WS_WSU),  SSM_W,   D_MODEL, SSM_W,   0,   0, 1,     0}; break;
    case 3:  t = TrJob{a.in[15], nullptr,  (bf16*)(ws + WS_WGLU), SSM_W,   SSM_W,   SSM_W,   0,   0, 1,     0}; break;
    case 4:  t = TrJob{a.in[18], nullptr,  (bf16*)(ws + WS_WOUT), D_MODEL, D_MODEL, D_MODEL, 0,   0, 1,     0}; break;
    case 5:  t = TrJob{a.in[22], a.in[19], (bf16*)(ws + WS_WEGU), D_MODEL, EXP_D,   D_MODEL, 0,   0, N_EXP, 256}; break;
    case 6:  t = TrJob{a.in[23], a.in[19], (bf16*)(ws + WS_WEGU), D_MODEL, EXP_D,   D_MODEL, 128, 0, N_EXP, 256}; break;
    case 7:  t = TrJob{a.in[24], nullptr,  (bf16*)(ws + WS_WED),  EXP_D,   D_MODEL, EXP_D,   0,   0, N_EXP, D_MODEL}; break;
    case 8:  t = TrJob{a.in[25], a.in[19], (bf16*)(ws + WS_WSGU), D_MODEL, SH_D,    D_MODEL, 0,   2, 1,     0}; break;
    case 9:  t = TrJob{a.in[26], a.in[19], (bf16*)(ws + WS_WSGU), D_MODEL, SH_D,    D_MODEL, 128, 2, 1,     0}; break;
    case 10: t = TrJob{a.in[27], nullptr,  (bf16*)(ws + WS_WSD),  SH_D,    D_MODEL, SH_D,    0,   0, 1,     0}; break;
    case 11: t = TrJob{a.in[29], a.in[28], (bf16*)(ws + WS_WPG),  D_MODEL, D_MODEL, D_MODEL, 0,   0, 1,     0}; break;
    default: t = TrJob{a.in[30], nullptr,  (bf16*)(ws + WS_WPP),  PLE_D,   D_MODEL, PLE_D,   0,   0, 1,     0}; break;
    }
    return t;
}
__device__ __forceinline__ void row_to_bf16_rstd(const float* xrow, bf16* orow, float* rstd_out, int lane) {
    const GAS f32x4* xr = (const GAS f32x4*)xrow + lane;
    f32x4 v[4]; float s = 0.f;
#pragma unroll
    for (int j = 0; j < 4; ++j) { v[j] = xr[64 * j]; s += (v[j].x * v[j].x + v[j].y * v[j].y) + (v[j].z * v[j].z + v[j].w * v[j].w); }
    s = wave_sum(s);
    if (lane == 0) *rstd_out = rsqrtf(s * (1.f / D_MODEL) + EPS);
    GAS v2u* o8 = (GAS v2u*)orow + lane;
#pragma unroll
    for (int j = 0; j < 4; ++j) o8[64 * j] = (v2u){pk2(v[j].x, v[j].y), pk2(v[j].z, v[j].w)};
}

template <int NR, int MODE>
__device__ __forceinline__ void rows_pass(const float* src, bf16* dstb, float* aux, const float* gain, int row0, int stride, int lane) {
    f32x4 v[NR][4];
#pragma unroll
    for (int q = 0; q < NR; ++q) { const GAS f32x4* xr = (const GAS f32x4*)(src + (size_t)(row0 + q * stride) * D_MODEL) + lane;
#pragma unroll
        for (int j = 0; j < 4; ++j) v[q][j] = xr[64 * j]; }
#pragma unroll
    for (int q = 0; q < NR; ++q) { const size_t row = (size_t)(row0 + q * stride); float s = 0.f;
#pragma unroll
        for (int j = 0; j < 4; ++j) s += (v[q][j].x * v[q][j].x + v[q][j].y * v[q][j].y) + (v[q][j].z * v[q][j].z + v[q][j].w * v[q][j].w);
        const float rs = rsqrtf(wave_sum(s) * (1.f / D_MODEL) + EPS);
        if (MODE == 0) { if (lane == 0) aux[row] = rs; GAS v2u* o8 = (GAS v2u*)(dstb + row * D_MODEL) + lane;
#pragma unroll
            for (int j = 0; j < 4; ++j) o8[64 * j] = (v2u){cvt_pk_bf16(v[q][j].x, v[q][j].y), cvt_pk_bf16(v[q][j].z, v[q][j].w)}; }
        else if (MODE == 1) { GAS v2u* o8 = (GAS v2u*)(dstb + row * D_MODEL) + lane;
#pragma unroll
            for (int j = 0; j < 4; ++j) o8[64 * j] = (v2u){cvt_pk_bf16(v[q][j].x * rs, v[q][j].y * rs), cvt_pk_bf16(v[q][j].z * rs, v[q][j].w * rs)}; }
        else { GAS f32x4* o = (GAS f32x4*)(aux + row * D_MODEL) + lane;
#pragma unroll
            for (int j = 0; j < 4; ++j) { const f32x4 gg = *((const GAS f32x4*)gain + lane + 64 * j); o[64 * j] = v[q][j] * rs * gg; } }
    }
}
__device__ __forceinline__ void row_norm_bf16(const float* xrow, bf16* orow, int lane) {
    const GAS f32x4* xr = (const GAS f32x4*)xrow + lane;
    f32x4 v[4]; float s = 0.f;
#pragma unroll
    for (int j = 0; j < 4; ++j) { v[j] = xr[64 * j]; s += (v[j].x * v[j].x + v[j].y * v[j].y) + (v[j].z * v[j].z + v[j].w * v[j].w); }
    const float rs = rsqrtf(wave_sum(s) * (1.f / D_MODEL) + EPS);
    GAS v2u* o8 = (GAS v2u*)orow + lane;
#pragma unroll
    for (int j = 0; j < 4; ++j) o8[64 * j] = (v2u){cvt_pk_bf16(v[j].x * rs, v[j].y * rs), cvt_pk_bf16(v[j].z * rs, v[j].w * rs)};
}
struct EpiInProj {
    static constexpr bool PERM = false;
    const float* rstd; const LAS float* rope; const float* qn; const float* kn;
    bf16 *Q, *K, *V, *ucat, *GA, *GS;
    struct Pre { float rs1[2][4]; };
    __device__ __forceinline__ void prefetch(Pre& P, const pg8::Unit& u, int wr, int fr) const {
#pragma unroll
        for (int ai = 0; ai < 2; ++ai)
#pragma unroll
            for (int m = 0; m < 4; ++m) P.rs1[ai][m] = rstd[u.pm * 256 + wr * 64 + fr + ai * 128 + m * 16]; }
    __device__ __forceinline__ void operator()(const f32x4 (&acc)[2][2][4][2], const pg8::Unit& u, int wr, int wc, int fr, int fq, const Pre& P) const {
        const int pn = u.pn; const int rbase = u.pm * 256 + wr * 64 + fr;
        if (pn <= 2) {
            const bool isq = pn < 2;
            if (isq || wc < 2) {
                const float* nw = isq ? qn : kn; f32x4 w[2][2];
#pragma unroll
                for (int bj = 0; bj < 2; ++bj)
#pragma unroll
                    for (int n = 0; n < 2; ++n) w[bj][n] = *(const f32x4*)(nw + 32 * bj + 16 * n + 4 * fq);
                const float osc = isq ? C2 : 1.f;
#pragma unroll
                for (int ai = 0; ai < 2; ++ai)
#pragma unroll
                  for (int mp = 0; mp < 2; ++mp) {
                    f32x4 rcs[1][2], ccs2[2][2];
                    { const int coord = ((u.pm * 256 + ai * 128 + wr * 64) & (SEQ - 1)) >> 6;
                      rcs[0][0] = *(const LAS f32x4*)(rope + (coord * 16 + 4 * fq) * 2); rcs[0][1] = *(const LAS f32x4*)(rope + (coord * 16 + 4 * fq) * 2 + 4); }
#pragma unroll
                    for (int mq = 0; mq < 2; ++mq) { const int coord = (2 * mp + mq) * 16 + fr;
                        ccs2[mq][0] = *(const LAS f32x4*)(rope + (coord * 16 + 4 * fq) * 2); ccs2[mq][1] = *(const LAS f32x4*)(rope + (coord * 16 + 4 * fq) * 2 + 4); }
                    asm volatile("" ::: "memory");
#pragma unroll
                    for (int mq = 0; mq < 2; ++mq) { const int m = 2 * mp + mq;
                        const int r = rbase + ai * 128 + m * 16;
                        f32x4 v[2][2]; float ss = 0.f;
#pragma unroll
                        for (int bj = 0; bj < 2; ++bj)
#pragma unroll
                            for (int n = 0; n < 2; ++n) { v[bj][n] = acc[ai][bj][m][n] * P.rs1[ai][m]; ss += (v[bj][n].x * v[bj][n].x + v[bj][n].y * v[bj][n].y) + (v[bj][n].z * v[bj][n].z + v[bj][n].w * v[bj][n].w); }
                        ss += __shfl_xor(ss, 16); ss += __shfl_xor(ss, 32);
                        const float rs = rsqrtf(ss * (1.f / 64.f) + EPS);
                        bf16* dst = isq ? (Q + (size_t)r * Q_W + (pn * 4 + wc) * 64) : (K + (size_t)r * KV_W + wc * 64);
#pragma unroll
                        for (int bj = 0; bj < 2; ++bj) {
                            const f32x4 cs0 = bj ? ccs2[mq][0] : rcs[0][0], cs1 = bj ? ccs2[mq][1] : rcs[0][1];
                            const f32x4 cc = (f32x4){cs0.x, cs0.z, cs1.x, cs1.z}, sn = (f32x4){cs0.y, cs0.w, cs1.y, cs1.w};
                            const f32x4 x1 = v[bj][0] * rs * w[bj][0], x2 = v[bj][1] * rs * w[bj][1];
                            const f32x4 o1 = (x1 * cc - x2 * sn) * osc, o2 = (x2 * cc + x1 * sn) * osc;
                            *(v2u*)(dst + 32 * bj + 4 * fq) = (v2u){cvt_pk_bf16(o1.x, o1.y), cvt_pk_bf16(o1.z, o1.w)};
                            *(v2u*)(dst + 32 * bj + 16 + 4 * fq) = (v2u){cvt_pk_bf16(o2.x, o2.y), cvt_pk_bf16(o2.z, o2.w)};
                        }
                    }
                    asm volatile("" ::: "memory");
                  }
            } else {
#pragma unroll
                for (int ai = 0; ai < 2; ++ai)
#pragma unroll
                    for (int m = 0; m < 4; ++m) {
                        const int r = rbase + ai * 128 + m * 16;
                        bf16* dst = V + (size_t)r * KV_W + (wc - 2) * 64 + 4 * fq;
#pragma unroll
                        for (int bj = 0; bj < 2; ++bj)
#pragma unroll
                            for (int n = 0; n < 2; ++n) { const f32x4 v = acc[ai][bj][m][n] * P.rs1[ai][m]; *(v2u*)(dst + 32 * bj + 16 * n) = (v2u){cvt_pk_bf16(v.x, v.y), cvt_pk_bf16(v.z, v.w)}; }
                    }
            }
        } else if (pn == 3) {
#pragma unroll
            for (int ai = 0; ai < 2; ++ai)
#pragma unroll
                for (int m = 0; m < 4; ++m) {
                    const int r = rbase + ai * 128 + m * 16;
                    bf16* dst = ucat + (size_t)(r >> 6) * UCAT_LD + (r & 63) * SSM_G + 4 * fq;
#pragma unroll
                    for (int bj = 0; bj < 2; ++bj)
#pragma unroll
                        for (int n = 0; n < 2; ++n) { const f32x4 v = acc[ai][bj][m][n] * P.rs1[ai][m]; const int g = 8 * bj + 2 * wc + n;
                            *(v2u*)(dst + (size_t)g * (BATCH * NCHUNK) * UCAT_LD) = (v2u){cvt_pk_bf16(v.x, v.y), cvt_pk_bf16(v.z, v.w)}; }
                }
        } else {
            bf16* G = (pn < 8) ? GA : GS; const int cb = ((pn - 4) & 3) * 256 + wc * 32 + 4 * fq;
#pragma unroll
            for (int ai = 0; ai < 2; ++ai)
#pragma unroll
                for (int m = 0; m < 4; ++m) {
                    const int r = rbase + ai * 128 + m * 16;
                    bf16* dst = G + (size_t)r * D_MODEL + cb;
#pragma unroll
                    for (int bj = 0; bj < 2; ++bj)
#pragma unroll
                        for (int n = 0; n < 2; ++n) { const f32x4 v = acc[ai][bj][m][n] * P.rs1[ai][m];
                            *(v2u*)(dst + 128 * bj + 16 * n) = (v2u){cvt_pk_bf16(fsig(v.x), fsig(v.y)), cvt_pk_bf16(fsig(v.z), fsig(v.w))}; }
                }
        }
    }
};
#include <hip/hip_bf16.h>
namespace attn_body {
using bf16=__hip_bfloat16;
using bf16x8=__attribute__((ext_vector_type(8)))short;
using s16x4=__attribute__((ext_vector_type(4)))short;
using f32x16=__attribute__((ext_vector_type(16)))float;
using u32x4=__attribute__((ext_vector_type(4)))unsigned;
constexpr int BATCH=32,NHEAD=8,NKV=2,SEQ=2048,D=64,QP=NHEAD*D,KP=NKV*D;
constexpr int NW=8,QBLK=32,QB=QBLK*NW,KVBLK=64,NQB=SEQ/QB;
constexpr int ATTN_UNIT_ROWS=QB;
__device__ __forceinline__ int crow(int r,int hi){return (r&3)+8*(r>>2)+4*hi;}
#define SBAR() __builtin_amdgcn_sched_barrier(0)
__device__ __forceinline__ void cmask(f32x16&p0,f32x16&p1,int jb,int qrel,int hi){
  const float NEG=-INFINITY; int kb=64*jb+4*hi;
  #pragma unroll
  for(int r=0;r<16;++r){int kv=kb+(r&3)+8*(r>>2); if(kv>qrel)p0[r]=NEG; if(kv+32>qrel)p1[r]=NEG;}
}

constexpr int NSLOT=3, SLOTB=8192;
constexpr int LDS_K=0, LDS_V=NSLOT*SLOTB, LDS_WS=2*NSLOT*SLOTB, LDS_OST=LDS_WS+NW*64*4, LDS_BYTES=LDS_OST+NW*4096;
constexpr float C2=0.125f*1.4426950408889634f;
__device__ __forceinline__ void glds16(const void*gsrc,unsigned lds_dst){unsigned keep;
  asm volatile("s_mov_b32 %0, m0\n\ts_mov_b32 m0, %2\n\ts_nop 0\n\tglobal_load_lds_dwordx4 %1, off\n\ts_mov_b32 m0, %0":"=&s"(keep):"v"(gsrc),"s"(lds_dst):"memory");}
__device__ __forceinline__ float max3f(float a,float b,float c){float r;asm("v_max3_f32 %0, %1, %2, %3":"=v"(r):"v"(a),"v"(b),"v"(c));return r;}
__device__ __forceinline__ float max2f(float a,float b){float r;asm("v_max_f32_e32 %0, %1, %2":"=v"(r):"v"(a),"v"(b));return r;}
__device__ __forceinline__ float fadd_s(float a,float b){float r;asm("v_add_f32_e32 %0, %1, %2":"=v"(r):"v"(a),"v"(b));return r;}
__device__ __forceinline__ float fsub_s(float a,float b){float r;asm("v_sub_f32_e32 %0, %1, %2":"=v"(r):"v"(a),"v"(b));return r;}
typedef float f32x2_t __attribute__((ext_vector_type(2))); typedef __bf16 bf16x2_t __attribute__((ext_vector_type(2)));
__device__ __forceinline__ unsigned cvtpk_s(float lo,float hi){f32x2_t v={lo,hi};bf16x2_t b=__builtin_convertvector(v,bf16x2_t);return __builtin_bit_cast(unsigned,b);}
#define WAIT_BAR(N) asm volatile("s_waitcnt vmcnt(" #N ") lgkmcnt(0)\n\ts_barrier":::"memory")

__device__ __forceinline__ void qkt(f32x16&p0,f32x16&p1,const char*Kslot,const bf16x8*qr,const f32x16&negm,int r32,int hi){
  const char*kb=Kslot+hi*1024+r32*16;
  #pragma unroll
  for(int d0=0;d0<4;++d0){
    const bf16x8 b0=*reinterpret_cast<const bf16x8*>(kb+d0*2048);
    const bf16x8 b1=*reinterpret_cast<const bf16x8*>(kb+d0*2048+512);
    if(d0==0){p0=__builtin_amdgcn_mfma_f32_32x32x16_bf16(b0,qr[0],negm,0,0,0);p1=__builtin_amdgcn_mfma_f32_32x32x16_bf16(b1,qr[0],negm,0,0,0);}
    else{p0=__builtin_amdgcn_mfma_f32_32x32x16_bf16(b0,qr[d0],p0,0,0,0);p1=__builtin_amdgcn_mfma_f32_32x32x16_bf16(b1,qr[d0],p1,0,0,0);}}
}
typedef __attribute__((address_space(3))) const char* lds_cptr;
typedef short v4i16_t __attribute__((ext_vector_type(4)));
__device__ __forceinline__ void kload8(bf16x8*kf,lds_cptr kp){
  kf[0]=*(const __attribute__((address_space(3))) bf16x8*)(kp);      kf[1]=*(const __attribute__((address_space(3))) bf16x8*)(kp+512);
  kf[2]=*(const __attribute__((address_space(3))) bf16x8*)(kp+2048); kf[3]=*(const __attribute__((address_space(3))) bf16x8*)(kp+2560);
  kf[4]=*(const __attribute__((address_space(3))) bf16x8*)(kp+4096); kf[5]=*(const __attribute__((address_space(3))) bf16x8*)(kp+4608);
  kf[6]=*(const __attribute__((address_space(3))) bf16x8*)(kp+6144); kf[7]=*(const __attribute__((address_space(3))) bf16x8*)(kp+6656);
}
__device__ __forceinline__ void kload2(bf16x8*kf,lds_cptr kp,int j){ kf[2*j]=*(const __attribute__((address_space(3))) bf16x8*)(kp+j*2048); kf[2*j+1]=*(const __attribute__((address_space(3))) bf16x8*)(kp+j*2048+512); }
__device__ __forceinline__ s16x4 vtr(lds_cptr p){ return __builtin_bit_cast(s16x4,__builtin_amdgcn_ds_read_tr16_b64_v4i16((__attribute__((address_space(3))) v4i16_t*)p)); }
__device__ __forceinline__ float rowmax(const f32x16&p0,const f32x16&p1){
  float a=max3f(p0[0],p0[1],p1[0]),b=max3f(p0[2],p0[3],p1[1]);a=max3f(a,p1[2],p1[3]);
  #pragma unroll
  for(int r=4;r<16;r+=4){a=max3f(a,p0[r],p0[r+1]);b=max3f(b,p0[r+2],p0[r+3]);a=max3f(a,p1[r],p1[r+1]);b=max3f(b,p1[r+2],p1[r+3]);}
  const float m=max2f(a,b);
  auto rr=__builtin_amdgcn_permlane32_swap(__float_as_uint(m),__float_as_uint(m),false,false);
  return max2f(__uint_as_float(rr[0]),__uint_as_float(rr[1]));
}
__device__ __forceinline__ void pv(f32x16*o,int vb,bf16x8 pa0,bf16x8 pa1,bf16x8 pa2,bf16x8 pa3){
  #pragma unroll
  for(int d0=0;d0<2;++d0){s16x4 lo[4],hi[4];
    #pragma unroll
    for(int ks=0;ks<4;++ks){
      asm volatile("ds_read_b64_tr_b16 %0,%1 offset:%c2":"=&v"(lo[ks]):"v"(vb),"i"(d0*4096+ks*1024):"memory");
      asm volatile("ds_read_b64_tr_b16 %0,%1 offset:%c2":"=&v"(hi[ks]):"v"(vb),"i"(d0*4096+ks*1024+512):"memory");}
    asm volatile("s_waitcnt lgkmcnt(0)":::"memory");SBAR();
    #define PK(k) (bf16x8){lo[k][0],lo[k][1],lo[k][2],lo[k][3],hi[k][0],hi[k][1],hi[k][2],hi[k][3]}
    o[d0]=__builtin_amdgcn_mfma_f32_32x32x16_bf16(pa0,PK(0),o[d0],0,0,0);
    o[d0]=__builtin_amdgcn_mfma_f32_32x32x16_bf16(pa1,PK(1),o[d0],0,0,0);
    o[d0]=__builtin_amdgcn_mfma_f32_32x32x16_bf16(pa2,PK(2),o[d0],0,0,0);
    o[d0]=__builtin_amdgcn_mfma_f32_32x32x16_bf16(pa3,PK(3),o[d0],0,0,0);
    #undef PK
  }
}

#ifndef ATTN_STORE16
#define ATTN_STORE16(p,v) (*(u32x4*)(p)=(v))
#endif
template<int THRL> __device__ __forceinline__ void attn_unit(int b,int h,int qb,const bf16*Q,const bf16*__restrict__ K,const bf16*__restrict__ V,bf16*O,char*shm){
  int tid=threadIdx.x; asm volatile("":"+v"(tid)); const int lane=tid&63,r32=lane&31,hi=lane>>5; const int wid=__builtin_amdgcn_readfirstlane(tid>>6);
  const long rowbase=(long)b*SEQ; const int q0=qb*QB; const int kvh=h/(NHEAD/NKV);
  const bf16*Qw=Q+(rowbase+q0+wid*QBLK)*QP+h*D;
  const bf16*Kh=K+rowbase*KP+kvh*D,*Vh=V+rowbase*KP+kvh*D;
  const unsigned lds0=(unsigned)(uintptr_t)shm;
  float*wsf=(float*)(shm+LDS_WS)+wid*64;
  const bf16*ksrc=Kh+(long)lane*KP+wid*8;
  const bf16*vsrc=Vh+(long)(16*(wid&3)+(lane>>2))*KP+(wid>>2)*32+(lane&3)*8;
  const unsigned kdst=lds0+LDS_K+wid*1024, vdst=lds0+LDS_V+wid*1024;
  #define DMA_K(t,slot) glds16(ksrc+(long)(t)*KVBLK*KP,(unsigned)__builtin_amdgcn_readfirstlane(kdst+(slot)))
  #define DMA_V(t,slot) glds16(vsrc+(long)(t)*KVBLK*KP,(unsigned)__builtin_amdgcn_readfirstlane(vdst+(slot)))
  const int vb0=(int)(lds0+LDS_V)+((lane>>4)&1)*32+(lane&3)*8+(4*hi+((lane&15)>>2))*64;
  const char*Kbase=shm+LDS_K; bf16x8 kf[8];
  const lds_cptr shm3=(lds_cptr)shm; const lds_cptr kp0=shm3+LDS_K+hi*1024+r32*16; const lds_cptr vp0=shm3+LDS_V+((lane>>4)&1)*32+(lane&3)*8+(4*hi+((lane&15)>>2))*64;
  constexpr int NT=SEQ/KVBLK;
  DMA_K(0,0);DMA_V(0,0);DMA_K(1,SLOTB);
  bf16x8 qr[4];
  #pragma unroll
  for(int d0=0;d0<4;++d0)qr[d0]=*reinterpret_cast<const bf16x8*>(&Qw[(long)r32*QP+d0*16+hi*8]);
  float mhat=0.f,l_reg=0.f;f32x16 o[2];o[0]=f32x16{};o[1]=f32x16{};f32x16 negm=f32x16{};asm volatile("":"+v"(negm));
  #define CMASK(P0,P1,t) do{}while(0)
  bool resc=false;
  #define START(P0,P1) do{ const float rm=rowmax(P0,P1); resc=false; \
    { const float dl=rm; mhat=fadd_s(mhat,dl); \
      _Pragma("unroll") for(int r=0;r<16;++r){P0[r]=fsub_s(P0[r],dl);P1[r]=fsub_s(P1[r],dl);} \
      _Pragma("unroll") for(int r=0;r<16;++r)negm[r]=-mhat; asm volatile("":"+v"(negm)); } \
    _Pragma("unroll") for(int r=0;r<16;++r)P0[r]=__builtin_amdgcn_exp2f(P0[r]); }while(0)
  #define RESC() do{ if(resc){ asm volatile("s_waitcnt lgkmcnt(0)":::"memory"); \
      _Pragma("unroll") for(int d_=0;d_<2;++d_) _Pragma("unroll") for(int r=0;r<16;++r)o[d_][r]*=wsf[crow(r,hi)]; } }while(0)
  f32x16 pA0,pA1,pB0,pB1;
  int sl_prev=0,sl_cur=0,sl_next=SLOTB;
  #define ROT() do{sl_prev=sl_cur;sl_cur=sl_next;sl_next=(sl_next==(NSLOT-1)*SLOTB)?0:sl_next+SLOTB;}while(0)
  DMA_K(2,2*SLOTB);
  WAIT_BAR(3);
  qkt(pA0,pA1,Kbase,qr,negm,r32,hi);asm volatile("s_nop 15\n\ts_nop 7":"+v"(pA0),"+v"(pA1));CMASK(pA0,pA1,0);
  START(pA0,pA1);
  _Pragma("unroll") for(int r=0;r<16;++r)pA1[r]=__builtin_amdgcn_exp2f(pA1[r]);
  WAIT_BAR(0);
  DMA_K(3,0);DMA_V(1,SLOTB);
  ROT();
  kload8(kf,kp0+sl_cur);
  WAIT_BAR(2);
  s16x4 vlo[8],vhi[8]; u32x4 pw0,pw1,pw2,pw3;
  #define PKW(P,B) cvtpk_s(P[B],P[B+1])
  #define PAF(k) __builtin_bit_cast(bf16x8,pw##k)
  #define VFR(i) (bf16x8){vlo[i][0],vlo[i][1],vlo[i][2],vlo[i][3],vhi[i][0],vhi[i][1],vhi[i][2],vhi[i][3]}
  #define PIN(x) asm volatile("":"+v"(x))
  #define MX3(a,b,c) __builtin_fmaxf(__builtin_fmaxf((a),(b)),(c))
  #define GAPA(MF,A0,A1,A2,A3,W0,W1,PW) do{ MF; sacc+=A0; sacc+=A1; sacc+=A2; sacc+=A3; PIN(sacc); W0; W1; PIN(PW); SBAR(); }while(0)
  #define EX(v) __builtin_amdgcn_exp2f(v)
  #define GAPB(MF,X,B) do{ MF; X[B]=EX(X[B]); X[B+1]=EX(X[B+1]); X[B+2]=EX(X[B+2]); X[B+3]=EX(X[B+3]); PIN(X); SBAR(); }while(0)
  #define VRD(i) do{ vlo[i]=vtr(vp_+(((i)>>2)*4096+((i)&3)*1024)); vhi[i]=vtr(vp_+(((i)>>2)*4096+((i)&3)*1024+512)); }while(0)
  #define KRD(G,j) do{ if(G){ kload2(kf,kp0+sl_next,j); SBAR(); } }while(0)
  #define STEP(C0,C1,P0,P1,t,GK,GV,GL) do{ SBAR(); \
    const lds_cptr vp_=vp0+sl_prev; \
    VRD(0); SBAR(); float sacc=(P0[0]+P0[1]); \
    GAPA(C0=__builtin_amdgcn_mfma_f32_32x32x16_bf16(kf[0],qr[0],negm,0,0,0), P0[2],P0[3],P0[4],P0[5],     pw0[0]=PKW(P0,0), pw0[1]=PKW(P0,2), pw0); \
    VRD(4); SBAR(); GAPA(C1=__builtin_amdgcn_mfma_f32_32x32x16_bf16(kf[1],qr[0],negm,0,0,0), P0[6],P0[7],P0[8],P0[9],     pw0[2]=PKW(P0,4), pw0[3]=PKW(P0,6), pw0); \
    VRD(1); SBAR(); GAPA(C0=__builtin_amdgcn_mfma_f32_32x32x16_bf16(kf[2],qr[1],C0,0,0,0),   P0[10],P0[11],P0[12],P0[13], pw1[0]=PKW(P0,8), pw1[1]=PKW(P0,10), pw1); \
    VRD(5); SBAR(); GAPA(C1=__builtin_amdgcn_mfma_f32_32x32x16_bf16(kf[3],qr[1],C1,0,0,0),   P0[14],P0[15],P1[0],P1[1],   pw1[2]=PKW(P0,12),pw1[3]=PKW(P0,14), pw1); \
    VRD(2); SBAR(); GAPA(C0=__builtin_amdgcn_mfma_f32_32x32x16_bf16(kf[4],qr[2],C0,0,0,0),   P1[2],P1[3],P1[4],P1[5],     pw2[0]=PKW(P1,0), pw2[1]=PKW(P1,2), pw2); \
    VRD(6); SBAR(); GAPA(C1=__builtin_amdgcn_mfma_f32_32x32x16_bf16(kf[5],qr[2],C1,0,0,0),   P1[6],P1[7],P1[8],P1[9],     pw2[2]=PKW(P1,4), pw2[3]=PKW(P1,6), pw2); \
    VRD(3); SBAR(); GAPA(C0=__builtin_amdgcn_mfma_f32_32x32x16_bf16(kf[6],qr[3],C0,0,0,0),   P1[10],P1[11],P1[12],P1[13], pw3[0]=PKW(P1,8), pw3[1]=PKW(P1,10), pw3); \
    VRD(7); SBAR(); GAPA(C1=__builtin_amdgcn_mfma_f32_32x32x16_bf16(kf[7],qr[3],C1,0,0,0),   P1[14],P1[15],0.f,0.f,       pw3[2]=PKW(P1,12),pw3[3]=PKW(P1,14), pw3); \
    l_reg+=sacc; \
    if(GK){DMA_K((t)+3,sl_cur);} if(GV){DMA_V((t)+1,sl_next);} \
    CMASK(C0,C1,t); \
    { float a=MX3(C0[0],C0[1],C1[0]),b=MX3(C0[2],C0[3],C1[1]); a=MX3(a,C1[2],C1[3]); \
      _Pragma("unroll") for(int r=4;r<16;r+=4){a=MX3(a,C0[r],C0[r+1]);b=MX3(b,C0[r+2],C0[r+3]);a=MX3(a,C1[r],C1[r+1]);b=MX3(b,C1[r+2],C1[r+3]);} \
      float rm=__builtin_fmaxf(a,b); { auto rr=__builtin_amdgcn_permlane32_swap(__float_as_uint(rm),__float_as_uint(rm),false,false); rm=__builtin_fmaxf(__uint_as_float(rr[0]),__uint_as_float(rr[1])); } \
      resc=false; \
      if(__builtin_expect(__any(rm>(float)THRL),0)){ const float dl=__builtin_fmaxf(rm,0.f); mhat+=dl; \
        _Pragma("unroll") for(int r=0;r<16;++r){C0[r]-=dl;C1[r]-=dl;} \
        _Pragma("unroll") for(int r=0;r<16;++r)negm[r]=-mhat; asm volatile("":"+v"(negm)); \
        const float f=__builtin_amdgcn_exp2f(-dl); l_reg*=f; if(hi==0)wsf[r32]=f; resc=true; } } \
    SBAR(); \
    GAPB(o[0]=__builtin_amdgcn_mfma_f32_32x32x16_bf16(PAF(0),VFR(0),o[0],0,0,0), C0,0); \
    GAPB(o[1]=__builtin_amdgcn_mfma_f32_32x32x16_bf16(PAF(0),VFR(4),o[1],0,0,0), C0,4); \
    KRD(GL,0); GAPB(o[0]=__builtin_amdgcn_mfma_f32_32x32x16_bf16(PAF(1),VFR(1),o[0],0,0,0), C0,8); \
    KRD(GL,1); GAPB(o[1]=__builtin_amdgcn_mfma_f32_32x32x16_bf16(PAF(1),VFR(5),o[1],0,0,0), C0,12); \
    KRD(GL,2); GAPB(o[0]=__builtin_amdgcn_mfma_f32_32x32x16_bf16(PAF(2),VFR(2),o[0],0,0,0), C1,0); \
    KRD(GL,3); GAPB(o[1]=__builtin_amdgcn_mfma_f32_32x32x16_bf16(PAF(2),VFR(6),o[1],0,0,0), C1,4); \
    GAPB(o[0]=__builtin_amdgcn_mfma_f32_32x32x16_bf16(PAF(3),VFR(3),o[0],0,0,0), C1,8); \
    GAPB(o[1]=__builtin_amdgcn_mfma_f32_32x32x16_bf16(PAF(3),VFR(7),o[1],0,0,0), C1,12); \
    }while(0)
  int t=1;
  #undef CMASK
  #define CMASK(P0,P1,t) do{}while(0)
  for(;t+5<NT;t+=2){
    STEP(pB0,pB1,pA0,pA1,t,true,true,true);     WAIT_BAR(2); RESC(); ROT();
    STEP(pA0,pA1,pB0,pB1,t+1,true,true,true);   WAIT_BAR(2); RESC(); ROT();
  }
  #undef CMASK
  #define CMASK(P0,P1,t) do{}while(0)
  #define ENDW(tt) do{ if((tt)+3<NT){WAIT_BAR(2);} else if((tt)+2<NT){WAIT_BAR(1);} else {WAIT_BAR(0);} }while(0)
  for(;t+1<NT;t+=2){
    STEP(pB0,pB1,pA0,pA1,t,(t+3<NT),(t+1<NT),(t+1<NT));       ENDW(t);   RESC(); ROT();
    STEP(pA0,pA1,pB0,pB1,t+1,(t+4<NT),(t+2<NT),(t+2<NT));     ENDW(t+1); RESC(); ROT();
  }
  STEP(pB0,pB1,pA0,pA1,NT-1,false,false,false); RESC();
  { float sacc=pB0[0]+pB0[1]; _Pragma("unroll") for(int r=2;r<16;++r)sacc+=pB0[r]; _Pragma("unroll") for(int r=0;r<16;++r)sacc+=pB1[r]; l_reg+=sacc;
    pw0=(u32x4){PKW(pB0,0),PKW(pB0,2),PKW(pB0,4),PKW(pB0,6)};pw1=(u32x4){PKW(pB0,8),PKW(pB0,10),PKW(pB0,12),PKW(pB0,14)};pw2=(u32x4){PKW(pB1,0),PKW(pB1,2),PKW(pB1,4),PKW(pB1,6)};pw3=(u32x4){PKW(pB1,8),PKW(pB1,10),PKW(pB1,12),PKW(pB1,14)};
    SBAR(); pv(o,vb0+sl_cur,PAF(0),PAF(1),PAF(2),PAF(3)); }
  #undef PKW
  #undef PAF
  #undef VFR
  #undef PIN
  #undef MX3
  #undef GAPA
  #undef GAPB
  #undef EX
  #undef VRD
  #undef KRD
  #undef STEP
  #undef ENDW
  {auto rr=__builtin_amdgcn_permlane32_swap(__float_as_uint(l_reg),__float_as_uint(l_reg),false,false);l_reg=__uint_as_float(rr[0])+__uint_as_float(rr[1]);}
  if(hi==0)wsf[32+r32]=l_reg;asm volatile("s_waitcnt lgkmcnt(0)":::"memory");
  float rli[16];
  #pragma unroll
  for(int r=0;r<16;++r)rli[r]=__builtin_amdgcn_rcpf(wsf[32+crow(r,hi)]);
  bf16*Ow=O+(rowbase+q0+wid*QBLK)*QP+h*D;
  { bf16*stg=(bf16*)(shm+LDS_OST)+wid*2048;
    #pragma unroll
    for(int r=0;r<16;++r){const int orow=crow(r,hi);
      #pragma unroll
      for(int d0=0;d0<2;++d0)stg[orow*64+d0*32+r32]=__float2bfloat16(o[d0][r]*rli[r]);}
    asm volatile("s_waitcnt lgkmcnt(0)":::"memory");
    #pragma unroll
    for(int i=0;i<4;++i){const int row=i*8+(lane>>3),ch=lane&7; const u32x4 v=*(const u32x4*)(stg+row*64+ch*8); ATTN_STORE16(Ow+(long)row*QP+ch*8,v);} }
  asm volatile("s_waitcnt lgkmcnt(0)\n\ts_barrier":::"memory");
  #undef DMA_K
  #undef DMA_V
  #undef CMASK
  #undef START
  #undef RESC
  #undef ROT
}
constexpr int ATTN_LDS_BYTES=LDS_BYTES;
struct AttnTensors { const bf16* Q; const bf16* K; const bf16* V; bf16* O; };
struct AttnUnit { int bh; int qb; };
struct StaticOrder {
  int vcu, grid;
  __device__ __forceinline__ explicit StaticOrder(int grid_,int vcu_):vcu(vcu_),grid(grid_){}
  __device__ __forceinline__ bool next(int i,AttnUnit&u)const{ const int pair=vcu+(i>>3)*grid; if(pair>=BATCH*NHEAD)return false; const int bk=pair>>2; u.bh=(bk>>1)*NHEAD+(bk&1)*(NHEAD/NKV)+(pair&3); u.qb=i&7; return true; }
  __device__ __forceinline__ void a_ready(const AttnUnit&)const{}
  __device__ __forceinline__ void done(const AttnUnit&)const{}
};
template<class Sched,int THRL=8> __device__ __forceinline__ void attn_phase(char*lds,const AttnTensors&T,const Sched&S){
  AttnUnit u;
  for(int i=0;S.next(i,u);++i){ S.a_ready(u); attn_unit<THRL>(u.bh/NHEAD,u.bh%NHEAD,u.qb,T.Q,T.K,T.V,T.O,lds); S.done(u); }
}
#undef SBAR
#undef WAIT_BAR
}
struct SsmLane { float are, aim, dt, cfr, cfi; };
__device__ __forceinline__ void cpow_(const SsmLane& L, float e, float& re, float& im) { const float mag = __expf(e * L.are * L.dt); float sn, cs; sincosf(e * L.aim * L.dt, &sn, &cs); re = mag * cs; im = mag * sn; }
__device__ __forceinline__ SsmLane ssm_lane(const float* a_re, const float* a_im, const float* log_dt, int gi, int p) {
    SsmLane L; L.are = a_re[gi * SSM_P + p]; L.aim = a_im[gi * SSM_P + p]; L.dt = expf(log_dt[gi]);
    float abr, abi; cpow_(L, 1.f, abr, abi);
    const float nr = abr - 1.f, ni = abi, den = L.are * L.are + L.aim * L.aim;
    L.cfr = (nr * L.are + ni * L.aim) / den; L.cfi = (ni * L.are - nr * L.aim) / den; return L;
}
struct SsmIn { const float *a_re, *a_im, *log_dt, *b_re, *b_im, *c_re, *c_im, *d_skip; };
__device__ __forceinline__ void ssm_item_toep(const SsmIn& P, bf16* btcat, LAS float* scr, int item, int lane) {
    const int g = item / 127, tau = item % 127 - 63, at = tau < 0 ? -tau : tau;
    const int c = lane >> 2, c0 = (lane & 3) * 4;
    f32x4 out = (f32x4){0.f, 0.f, 0.f, 0.f};
    for (int dir = 0; dir < 2; ++dir) {
        if ((tau > 0 && dir == 1) || (tau < 0 && dir == 0)) continue;
        const int gi = dir * SSM_NG + g;
        const SsmLane L = ssm_lane(P.a_re, P.a_im, P.log_dt, gi, lane);
        float pr, pi; cpow_(L, (float)at, pr, pi);
        scr[2 * lane] = pr * L.cfr - pi * L.cfi; scr[2 * lane + 1] = pr * L.cfi + pi * L.cfr;
        LDS_WAIT(); asm volatile("" ::: "memory");
        for (int p = 0; p < SSM_P; ++p) {
            const float wr_ = scr[2 * p], wi_ = scr[2 * p + 1];
            const float cr = P.c_re[((size_t)gi * SSM_G + c) * SSM_P + p], ci = P.c_im[((size_t)gi * SSM_G + c) * SSM_P + p];
            const float zr = cr * wr_ - ci * wi_, zi = cr * wi_ + ci * wr_;
            const f32x4 br = *(const f32x4*)(P.b_re + ((size_t)gi * SSM_P + p) * SSM_G + c0), bi = *(const f32x4*)(P.b_im + ((size_t)gi * SSM_P + p) * SSM_G + c0);
            out += br * zr - bi * zi;
        }
        LDS_WAIT(); asm volatile("" ::: "memory");
    }
    if (tau == 0) { const float d = P.d_skip[g * SSM_G + c]; if (c == c0) out.x += d; if (c == c0 + 1) out.y += d; if (c == c0 + 2) out.z += d; if (c == c0 + 3) out.w += d; }
    const v2u pk = (v2u){cvt_pk_bf16(out.x, out.y), cvt_pk_bf16(out.z, out.w)};
    const int n = 64 - at;
    for (int q = 0; q < n; ++q) { const int s = tau >= 0 ? q : q + at, t = tau >= 0 ? q + at : q;
        *(GAS v2u*)(btcat + ((size_t)g * 1024 + t * SSM_G + c) * UCAT_LD + s * SSM_G + c0) = pk; }
}
__device__ __forceinline__ void ssm_item_out(const SsmIn& P, bf16* btcat, int item, int lane) {
    const int g = item >> 6, t = item & 63;
#pragma unroll
    for (int dir = 0; dir < 2; ++dir) {
        const int gi = dir * SSM_NG + g; const SsmLane L = ssm_lane(P.a_re, P.a_im, P.log_dt, gi, lane);
        float pr, pi; cpow_(L, dir ? (float)(64 - t) : (float)(t + 1), pr, pi);
        for (int c = 0; c < SSM_G; ++c) {
            const float cr = P.c_re[((size_t)gi * SSM_G + c) * SSM_P + lane], ci = P.c_im[((size_t)gi * SSM_G + c) * SSM_P + lane];
            *(GAS unsigned*)(btcat + ((size_t)g * 1024 + t * SSM_G + c) * UCAT_LD + 1024 + dir * 128 + 2 * lane) = cvt_pk_bf16(cr * pr - ci * pi, -(cr * pi + ci * pr));
        }
    }
}
__device__ __forceinline__ void ssm_item_state(const SsmIn& P, bf16* btst, int item, int lane) {
    const int g = item >> 6, s = item & 63;
#pragma unroll
    for (int dir = 0; dir < 2; ++dir) {
        const int gi = dir * SSM_NG + g; const SsmLane L = ssm_lane(P.a_re, P.a_im, P.log_dt, gi, lane);
        float pr, pi; cpow_(L, dir ? (float)s : (float)(63 - s), pr, pi);
        const float wr_ = pr * L.cfr - pi * L.cfi, wi_ = pr * L.cfi + pi * L.cfr;
        bf16* rre = btst + ((size_t)g * 256 + dir * 128 + 2 * lane) * 1024 + s * SSM_G; bf16* rim = rre + 1024;
#pragma unroll
        for (int q = 0; q < 4; ++q) {
            const f32x4 br = *(const f32x4*)(P.b_re + ((size_t)gi * SSM_P + lane) * SSM_G + 4 * q), bi = *(const f32x4*)(P.b_im + ((size_t)gi * SSM_P + lane) * SSM_G + 4 * q);
            const f32x4 vr = br * wr_ - bi * wi_, vi = br * wi_ + bi * wr_;
            *(GAS v2u*)(rre + 4 * q) = (v2u){cvt_pk_bf16(vr.x, vr.y), cvt_pk_bf16(vr.z, vr.w)};
            *(GAS v2u*)(rim + 4 * q) = (v2u){cvt_pk_bf16(vi.x, vi.y), cvt_pk_bf16(vi.z, vi.w)};
        }
    }
}
constexpr int SSM_I_TOEP = SSM_NG * 127, SSM_I_OUT = SSM_NG * 64, SSM_I_STATE = SSM_NG * 64, SSM_ITEMS = SSM_I_TOEP + SSM_I_OUT + SSM_I_STATE;

struct StateOrder { const char* ucat; const char* btst; int G, c;
    __device__ __forceinline__ bool next(int i, pg8::Unit& u) const { const int L = i * G + c; if (L >= SSM_NG * 4) return false; const int g = L >> 2; u.pm = L & 3; u.pn = 0; u.aux = g;
        u.A = ucat + ((size_t)g * 1024 + u.pm * 256) * (UCAT_LD * 2); u.B = btst + (size_t)g * 256 * 2048; u.rows = nullptr; u.nrows = 256; return true; } };
struct EpiState { static constexpr bool PERM = false; PG8_NO_PREFETCH; float* lst;
    __device__ __forceinline__ void operator()(const f32x4 (&acc)[2][2][4][2], const pg8::Unit& u, int wr, int wc, int fr, int fq, const Pre&) const {
#pragma unroll
        for (int ai = 0; ai < 2; ++ai)
#pragma unroll
            for (int m = 0; m < 4; ++m) { float* dst = lst + ((size_t)u.aux * 1024 + u.pm * 256 + ai * 128 + wr * 64 + m * 16 + fr) * 256 + wc * 32 + 4 * fq;
#pragma unroll
                for (int bj = 0; bj < 2; ++bj)
#pragma unroll
                    for (int n = 0; n < 2; ++n) *(f32x4*)(dst + 128 * bj + 16 * n) = acc[ai][bj][m][n]; }
    } };
__device__ __forceinline__ void ssm_carry(const SsmIn& P, const float* lst, bf16* ucat, int idx) {
    const int p = idx & 63, dir = (idx >> 6) & 1, b = (idx >> 7) & 31, g = idx >> 12;
    const SsmLane L = ssm_lane(P.a_re, P.a_im, P.log_dt, dir * SSM_NG + g, p);
    float ar, ai; cpow_(L, 64.f, ar, ai);
    float sr = 0.f, si = 0.f;
    for (int jj = 0; jj < NCHUNK; ++jj) { const int j = dir ? NCHUNK - 1 - jj : jj; const size_t row = (size_t)g * 1024 + b * NCHUNK + j;
        const f32x2 l = *(const f32x2*)(lst + row * 256 + dir * 128 + 2 * p);
        *(GAS unsigned*)(ucat + row * UCAT_LD + 1024 + dir * 128 + 2 * p) = pk2(sr, si);
        const float nr = ar * sr - ai * si + l.x, ni = ar * si + ai * sr + l.y; sr = nr; si = ni; }
}
struct YOrder { const char* ucat; const char* btcat; int G, c;
    __device__ __forceinline__ bool next(int i, pg8::Unit& u) const { const int L = i * G + c; if (L >= SSM_NG * 16) return false; const int g = L >> 4; u.pm = (L >> 2) & 3; u.pn = L & 3; u.aux = g;
        u.A = ucat + ((size_t)g * 1024 + u.pm * 256) * (UCAT_LD * 2); u.B = btcat + ((size_t)g * 1024 + u.pn * 256) * (UCAT_LD * 2); u.rows = nullptr; u.nrows = 256; return true; } };
struct EpiY { static constexpr bool PERM = false; PG8_NO_PREFETCH; bf16* yact;
    __device__ __forceinline__ void operator()(const f32x4 (&acc)[2][2][4][2], const pg8::Unit& u, int wr, int wc, int fr, int fq, const Pre&) const {
#pragma unroll
        for (int ai = 0; ai < 2; ++ai)
#pragma unroll
            for (int m = 0; m < 4; ++m) { const int chunk = u.pm * 256 + ai * 128 + wr * 64 + m * 16 + fr;
#pragma unroll
                for (int bj = 0; bj < 2; ++bj)
#pragma unroll
                    for (int n = 0; n < 2; ++n) { const int t = 16 * u.pn + 8 * bj + 2 * wc + n; f32x4 v = acc[ai][bj][m][n], o;
#pragma unroll
                        for (int j = 0; j < 4; ++j) { const float x = v[j]; o[j] = x * fsig(1.5957691216057308f * (x + 0.044715f * x * x * x)); }
                        *(v2u*)(yact + ((size_t)chunk * CH_T + t) * SSM_W + u.aux * SSM_G + 4 * fq) = (v2u){cvt_pk_bf16(o.x, o.y), cvt_pk_bf16(o.z, o.w)}; } }
    } };
__device__ __forceinline__ f32x4 unpack4(v2u w) { return (f32x4){__builtin_bit_cast(float, w.x << 16), __builtin_bit_cast(float, w.x & 0xffff0000u), __builtin_bit_cast(float, w.y << 16), __builtin_bit_cast(float, w.y & 0xffff0000u)}; }
__device__ __forceinline__ v2u pack4(f32x4 v) { return (v2u){cvt_pk_bf16(v.x, v.y), cvt_pk_bf16(v.z, v.w)}; }
#define EPI_WALK(u, BODY) do { _Pragma("unroll") for (int ai = 0; ai < 2; ++ai) _Pragma("unroll") for (int m = 0; m < 4; ++m) { const int r = (u).pm * 256 + ai * 128 + wr * 64 + m * 16 + fr; \
    _Pragma("unroll") for (int bj = 0; bj < 2; ++bj) _Pragma("unroll") for (int n = 0; n < 2; ++n) { const int col = (u).pn * 256 + 128 * bj + 32 * wc + 16 * n + 4 * fq; const f32x4 a4 = acc[ai][bj][m][n]; BODY } asm volatile("" ::: "memory"); } } while (0)
#define EPI_WALK_B(u, LOAD, BODY) do { _Pragma("unroll") for (int ai = 0; ai < 2; ++ai) { \
    _Pragma("unroll") for (int m = 0; m < 4; ++m) { const int r = (u).pm * 256 + ai * 128 + wr * 64 + m * 16 + fr; _Pragma("unroll") for (int bj = 0; bj < 2; ++bj) _Pragma("unroll") for (int n = 0; n < 2; ++n) { \
        const int col = (u).pn * 256 + 128 * bj + 32 * wc + 16 * n + 4 * fq; LOAD } } \
    asm volatile("" ::: "memory"); \
    _Pragma("unroll") for (int m = 0; m < 4; ++m) { const int r = (u).pm * 256 + ai * 128 + wr * 64 + m * 16 + fr; _Pragma("unroll") for (int bj = 0; bj < 2; ++bj) _Pragma("unroll") for (int n = 0; n < 2; ++n) { \
        const int col = (u).pn * 256 + 128 * bj + 32 * wc + 16 * n + 4 * fq; const f32x4 a4 = acc[ai][bj][m][n]; BODY } } \
    asm volatile("" ::: "memory"); } } while (0)
#define EPI_WALK_B2(u, LOAD, BODY) do { _Pragma("unroll") for (int ai = 0; ai < 2; ++ai) _Pragma("unroll") for (int mp = 0; mp < 2; ++mp) { \
    _Pragma("unroll") for (int mq = 0; mq < 2; ++mq) { const int m = 2 * mp + mq; const int r = (u).pm * 256 + ai * 128 + wr * 64 + m * 16 + fr; _Pragma("unroll") for (int bj = 0; bj < 2; ++bj) _Pragma("unroll") for (int n = 0; n < 2; ++n) { \
        const int col = (u).pn * 256 + 128 * bj + 32 * wc + 16 * n + 4 * fq; LOAD } } \
    asm volatile("" ::: "memory"); \
    _Pragma("unroll") for (int mq = 0; mq < 2; ++mq) { const int m = 2 * mp + mq; const int r = (u).pm * 256 + ai * 128 + wr * 64 + m * 16 + fr; _Pragma("unroll") for (int bj = 0; bj < 2; ++bj) _Pragma("unroll") for (int n = 0; n < 2; ++n) { \
        const int col = (u).pn * 256 + 128 * bj + 32 * wc + 16 * n + 4 * fq; const f32x4 a4 = acc[ai][bj][m][n]; BODY } } \
    asm volatile("" ::: "memory"); } } while (0)
struct EpiGlu { static constexpr bool PERM = false; PG8_NO_PREFETCH; bf16* y; const float* bglu;
    __device__ __forceinline__ void operator()(const f32x4 (&acc)[2][2][4][2], const pg8::Unit& u, int wr, int wc, int fr, int fq, const Pre&) const {
        f32x4 bv[2][2];
#pragma unroll
        for (int bj = 0; bj < 2; ++bj)
#pragma unroll
            for (int n = 0; n < 2; ++n) bv[bj][n] = *(const f32x4*)(bglu + 128 * bj + 32 * wc + 16 * n + 4 * fq);
        v2u yl[4][2][2];
        EPI_WALK_B(u, { yl[m][bj][n] = *(const v2u*)(y + (size_t)r * SSM_W + col); },
                      { const f32x4 yv = unpack4(yl[m][bj][n]); const f32x4 z = a4 + bv[bj][n];
                        *(v2u*)(y + (size_t)r * SSM_W + col) = pack4((f32x4){yv.x * fsig(z.x), yv.y * fsig(z.y), yv.z * fsig(z.z), yv.w * fsig(z.w)}); }); } };
template <bool FIRST> struct EpiMerge { static constexpr bool PERM = false; PG8_NO_PREFETCH; bf16* mbuf; const bf16* gate;
    __device__ __forceinline__ void operator()(const f32x4 (&acc)[2][2][4][2], const pg8::Unit& u, int wr, int wc, int fr, int fq, const Pre&) const {
        v2u gl[4][2][2], ml[4][2][2];
        EPI_WALK_B(u, { const size_t o = (size_t)r * D_MODEL + col; gl[m][bj][n] = *(const v2u*)(gate + o); if (!FIRST) ml[m][bj][n] = *(const v2u*)(mbuf + o); },
                      { const size_t o = (size_t)r * D_MODEL + col; const f32x4 gv = unpack4(gl[m][bj][n]);
                        if (FIRST) *(v2u*)(mbuf + o) = pack4(gv * a4); else *(v2u*)(mbuf + o) = pack4(unpack4(ml[m][bj][n]) + gv * a4); }); } };
struct EpiResid { static constexpr bool PERM = false; PG8_NO_PREFETCH; const float* base; float* out;
    __device__ __forceinline__ void operator()(const f32x4 (&acc)[2][2][4][2], const pg8::Unit& u, int wr, int wc, int fr, int fq, const Pre&) const {
        f32x4 bl[4][2][2];
        EPI_WALK_B(u, { bl[m][bj][n] = *(const f32x4*)(base + (size_t)r * D_MODEL + col); },
                      { *(f32x4*)(out + (size_t)r * D_MODEL + col) = bl[m][bj][n] + a4; }); } };
constexpr int EXP_CAP = NTOK;
constexpr int MAX_RTILES = (NTOK * TOP_K) / 256 + N_EXP;
constexpr int YS_W = 1024;
constexpr float FP8_SC = 32.f, FP8_ISC = 1.f / 32.f;
constexpr int LDS_TAB_OFF = LDSCTL_OFF + 1024;
static_assert(LDS_TAB_OFF + 2048 <= LDS_ROPE_OFF, "LDS tables");
struct MoeBufs { bf16* xn2; float* logit; int* cnt; int* list_tok; float* list_w; int* slot_e; int* slot_lp; const int* ident; bf16* hid; bf16* hsh; unsigned char* yslot; bf16* ysh; };

struct OneTileOrder { const char* A; const char* B; int G, c, ntiles; unsigned lda2;
    __device__ __forceinline__ bool next(int i, pg8::Unit& u) const { const int L = i * G + c; if (L >= ntiles) return false; u.pm = L; u.pn = 0; u.aux = 0; u.A = A + (size_t)L * 256 * lda2; u.B = B; u.rows = nullptr; u.nrows = 256; return true; } };
struct EpiRouter { static constexpr bool PERM = false; PG8_NO_PREFETCH; float* logit;
    __device__ __forceinline__ void operator()(const f32x4 (&acc)[2][2][4][2], const pg8::Unit& u, int wr, int wc, int fr, int fq, const Pre&) const {
#pragma unroll
        for (int ai = 0; ai < 2; ++ai)
#pragma unroll
            for (int m = 0; m < 4; ++m) { float* dst = logit + (size_t)(u.pm * 256 + ai * 128 + wr * 64 + m * 16 + fr) * 128 + 32 * wc + 4 * fq;
#pragma unroll
                for (int n = 0; n < 2; ++n) *(f32x4*)(dst + 16 * n) = acc[ai][0][m][n]; }
    } };
__device__ __forceinline__ void route_token(const float* lg, const float* rbias, int (&idx)[8], float (&wgt)[8]) {
    float s[64], bsd[64];
#pragma unroll
    for (int q = 0; q < 16; ++q) { const f32x4 h = *(const f32x4*)(lg + 4 * q), l = *(const f32x4*)(lg + 64 + 4 * q), b = *(const f32x4*)(rbias + 4 * q);
#pragma unroll
        for (int j = 0; j < 4; ++j) { s[4 * q + j] = sigmoidf_(h[j] + l[j]); bsd[4 * q + j] = s[4 * q + j] + b[j]; } }
    float gs[8];
#pragma unroll
    for (int g = 0; g < 8; ++g) { float m1 = -INFINITY, m2 = -INFINITY;
#pragma unroll
        for (int j = 0; j < 8; ++j) { const float v = bsd[g * 8 + j]; if (v > m1) { m2 = m1; m1 = v; } else if (v > m2) m2 = v; }
        gs[g] = m1 + m2; }
    unsigned gmask = 0;
#pragma unroll
    for (int k = 0; k < TOPK_G; ++k) { int best = 0; float bv = -INFINITY;
#pragma unroll
        for (int g = 0; g < 8; ++g) if (!((gmask >> g) & 1u) && gs[g] > bv) { bv = gs[g]; best = g; }
        gmask |= 1u << best; }
    unsigned long long emask = 0ull; float wsum = 0.f;
#pragma unroll
    for (int k = 0; k < TOP_K; ++k) { int best = 0; float bv = -INFINITY, sv = 0.f;
#pragma unroll
        for (int e = 0; e < 64; ++e) { const bool ok = ((gmask >> (e >> 3)) & 1u) && !((emask >> e) & 1ull); if (ok && bsd[e] > bv) { bv = bsd[e]; best = e; sv = s[e]; } }
        emask |= 1ull << best; idx[k] = best; wgt[k] = sv; wsum += sv; }
    const float sc = ROUTED_SCALE / wsum;
#pragma unroll
    for (int k = 0; k < TOP_K; ++k) wgt[k] *= sc;
}
__device__ __forceinline__ void moe_build_tab(LAS int* tab, const int* cnt, int tid) {
    if (tid < 64) tab[128 + tid] = __hip_atomic_load(cnt + tid, __ATOMIC_RELAXED, __HIP_MEMORY_SCOPE_AGENT);
    __syncthreads();
    if (tid == 0) { int s = 0; for (int e = 0; e < 64; ++e) { tab[e] = s; s += (tab[128 + e] + 255) >> 8; } tab[64] = s; }
    __syncthreads();
}
#define RFL(x) __builtin_amdgcn_readfirstlane(x)
__device__ __forceinline__ int moe_find(const LAS int* tab, int tile) { int e = 0;
#pragma unroll
    for (int j = 32; j >= 1; j >>= 1) if (RFL(tab[e + j]) <= tile) e += j;
    return e; }
struct GuOrder { const LAS int* tab; const char* xn2; const char* wegu; const char* wsgu; const int* list_tok; const int* ident; int G, c;
    __device__ __forceinline__ bool next(int i, pg8::Unit& u) const {
        const int L = i * G + c, TR = RFL(tab[64]);
        if (L < TR) { const int e = moe_find(tab, L), ti = L - RFL(tab[e]); u.pm = L; u.pn = ti; u.aux = e; u.A = xn2; u.B = wegu + (size_t)e * 256 * 2048; u.rows = list_tok + (size_t)e * EXP_CAP + ti * 256;
            const int left = RFL(tab[128 + e]) - ti * 256; u.nrows = left < 256 ? left : 256; return true; }
        const int s = L - TR; if (s >= (NTOK / 256) * 2) return false;
        u.pm = s >> 1; u.pn = s & 1; u.aux = 64 + (s & 1); u.A = xn2; u.B = wsgu + (size_t)(s & 1) * 256 * 2048; u.rows = ident + u.pm * 256; u.nrows = 256; return true; } };
struct EpiGu { static constexpr bool PERM = false; bf16* hid; bf16* hsh; const float* list_w;
    struct Pre { float wl[2][4]; };
    __device__ __forceinline__ void prefetch(Pre& P, const pg8::Unit& u, int wr, int fr) const { const bool routed = u.aux < 64;
#pragma unroll
        for (int ai = 0; ai < 2; ++ai)
#pragma unroll
            for (int mm = 0; mm < 4; ++mm) { const int row = ai * 128 + wr * 64 + mm * 16 + fr; P.wl[ai][mm] = (routed && row < u.nrows) ? list_w[(size_t)u.aux * EXP_CAP + u.pn * 256 + row] : (routed ? 0.f : 1.f); } }
    __device__ __forceinline__ void operator()(const f32x4 (&acc)[2][2][4][2], const pg8::Unit& u, int wr, int wc, int fr, int fq, const Pre& P) const {
        const bool routed = u.aux < 64;
#pragma unroll
        for (int ai = 0; ai < 2; ++ai)
#pragma unroll
            for (int mm = 0; mm < 4; ++mm) { const int row = ai * 128 + wr * 64 + mm * 16 + fr;
                const float w = P.wl[ai][mm]; bf16* dst;
                if (routed) dst = hid + ((size_t)u.pm * 256 + row) * EXP_D + 32 * wc + 4 * fq;
                else dst = hsh + ((size_t)u.pm * 256 + row) * SH_D + (u.aux - 64) * 128 + 32 * wc + 4 * fq;
#pragma unroll
                for (int n = 0; n < 2; ++n) { const f32x4 g4 = acc[ai][0][mm][n], u4 = acc[ai][1][mm][n]; f32x4 o;
#pragma unroll
                    for (int j = 0; j < 4; ++j) o[j] = g4[j] * fsig(g4[j]) * u4[j] * w;
                    *(v2u*)(dst + 16 * n) = pack4(o); }
                asm volatile("" ::: "memory"); }
    } };
struct DownOrder { const LAS int* tab; const char* hid; const char* wed; int G, c;
    __device__ __forceinline__ bool next(int i, pg8::Unit& u) const {
        const int L = i * G + c, TR = RFL(tab[64]); if (L >= 4 * TR) return false;
        const int tile = L >> 2, j = L & 3, e = moe_find(tab, tile);
        u.pm = tile; u.pn = j; u.aux = e; u.A = hid + (size_t)tile * 256 * (EXP_D * 2); u.B = wed + ((size_t)e * D_MODEL + j * 256) * (EXP_D * 2);
        u.rows = nullptr; u.nrows = 256; return true; } };
struct EpiFp8Store { static constexpr bool PERM = true; PG8_NO_PREFETCH; unsigned char* o;
    __device__ __forceinline__ void operator()(const f32x4 (&acc)[2][2][4][2], const pg8::Unit& u, int wr, int wc, int fr, int fq, const Pre&) const {
#pragma unroll
        for (int ai = 0; ai < 2; ++ai)
#pragma unroll
            for (int mm = 0; mm < 4; ++mm) { unsigned char* dst = o + ((size_t)u.pm * 256 + ai * 128 + wr * 64 + mm * 16 + fr) * YS_W + u.pn * 256 + 32 * wc + 8 * fq;
#pragma unroll
                for (int bj = 0; bj < 2; ++bj) { v2u w;
#pragma unroll
                    for (int n = 0; n < 2; ++n) { f32x4 v = acc[ai][bj][mm][n] * FP8_SC;
#pragma unroll
                        for (int q = 0; q < 4; ++q) v[q] = __builtin_fminf(__builtin_fmaxf(v[q], -448.f), 448.f);
                        int pk = __builtin_amdgcn_cvt_pk_fp8_f32(v.x, v.y, 0, false); pk = __builtin_amdgcn_cvt_pk_fp8_f32(v.z, v.w, pk, true); w[n] = (unsigned)pk; }
                    *(v2u*)(dst + 128 * bj) = w; } }
    } };
struct EpiBf16Store { static constexpr bool PERM = false; PG8_NO_PREFETCH; bf16* o; int ld;
    __device__ __forceinline__ void operator()(const f32x4 (&acc)[2][2][4][2], const pg8::Unit& u, int wr, int wc, int fr, int fq, const Pre&) const {
        EPI_WALK(u, { *(v2u*)(o + (size_t)r * ld + col) = pack4(a4); }); } };
__device__ __forceinline__ void moe_combine_row(float* hrow, bf16* yshrow  , const unsigned char* yslot, const int* se, const int* sl, const LAS int* tab, int lane) {
    const int c = lane * 16;
    int myslot = 0; if (lane < TOP_K) myslot = tab[se[lane]] * 256 + sl[lane];
    f32x4 a[4];
#pragma unroll
    for (int q = 0; q < 4; ++q) a[q] = *(const f32x4*)(hrow + c + 4 * q);
    const v4u s0 = *(const v4u*)(yshrow + c), s1 = *(const v4u*)(yshrow + c + 8);
    v4u sv[TOP_K];
#pragma unroll
    for (int k = 0; k < TOP_K; ++k) { const int sk = __builtin_amdgcn_readlane(myslot, k); sv[k] = *(const v4u*)(yslot + (size_t)sk * YS_W + c); }
    a[0] += unpack4((v2u){s0.x, s0.y}); a[1] += unpack4((v2u){s0.z, s0.w}); a[2] += unpack4((v2u){s1.x, s1.y}); a[3] += unpack4((v2u){s1.z, s1.w});
    f32x4 r8[4];
#pragma unroll
    for (int q = 0; q < 4; ++q) r8[q] = (f32x4){0.f, 0.f, 0.f, 0.f};
#pragma unroll
    for (int k = 0; k < TOP_K; ++k)
#pragma unroll
        for (int q = 0; q < 4; ++q) { const auto lo = __builtin_amdgcn_cvt_pk_f32_fp8((int)sv[k][q], false), hi = __builtin_amdgcn_cvt_pk_f32_fp8((int)sv[k][q], true);
            r8[q] += (f32x4){lo[0], lo[1], hi[0], hi[1]}; }
    float ss = 0.f;
#pragma unroll
    for (int q = 0; q < 4; ++q) { a[q] += r8[q] * FP8_ISC; *(f32x4*)(hrow + c + 4 * q) = a[q]; ss += (a[q].x * a[q].x + a[q].y * a[q].y) + (a[q].z * a[q].z + a[q].w * a[q].w); }
    const float rs = rsqrtf(wave_sum(ss) * (1.f / D_MODEL) + EPS);
    *(v4u*)(yshrow + c) = (v4u){cvt_pk_bf16(a[0].x * rs, a[0].y * rs), cvt_pk_bf16(a[0].z * rs, a[0].w * rs), cvt_pk_bf16(a[1].x * rs, a[1].y * rs), cvt_pk_bf16(a[1].z * rs, a[1].w * rs)};
    *(v4u*)(yshrow + c + 8) = (v4u){cvt_pk_bf16(a[2].x * rs, a[2].y * rs), cvt_pk_bf16(a[2].z * rs, a[2].w * rs), cvt_pk_bf16(a[3].x * rs, a[3].y * rs), cvt_pk_bf16(a[3].z * rs, a[3].w * rs)};
}
struct EpiPle { static constexpr bool PERM = false; PG8_NO_PREFETCH; float* h; const bf16* pp;
    __device__ __forceinline__ void operator()(const f32x4 (&acc)[2][2][4][2], const pg8::Unit& u, int wr, int wc, int fr, int fq, const Pre&) const {
        v2u pl[2][2][2]; f32x4 hl[2][2][2];
        EPI_WALK_B2(u, { const size_t o = (size_t)r * D_MODEL + col; pl[mq][bj][n] = *(const v2u*)(pp + o); hl[mq][bj][n] = *(const f32x4*)(h + o); },
                      { const size_t o = (size_t)r * D_MODEL + col; const f32x4 pv = unpack4(pl[mq][bj][n]); f32x4 hv = hl[mq][bj][n];
                        hv.x += fsig(a4.x) * pv.x; hv.y += fsig(a4.y) * pv.y; hv.z += fsig(a4.z) * pv.z; hv.w += fsig(a4.w) * pv.w; *(f32x4*)(h + o) = hv; }); } };
constexpr int PH_PROLOGUE = 0, PH_INPROJ = 1, PH_SSTATE = 2, PH_SCARRY = 3, PH_ATTN = 4, PH_GLU = 5, PH_MERGE_A = 6, PH_MERGE_B = 7, PH_OUTPROJ = 8, PH_ROUTE = 9, PH_EXP_GU = 10, PH_DOWN = 11, PH_COMB = 12, PH_PLE_PP = 13, PH_PLE_GATE = 14, PH_FINAL = 15, PH_END = 16;
__global__ void __launch_bounds__(NWAVES * 64, 2) mk_fwd(Args args) {
    __shared__ __attribute__((aligned(16))) unsigned char lds_raw[LDS_BYTES];
    LAS unsigned char* lds = (LAS unsigned char*)lds_raw;
    volatile LAS unsigned* MISC = (volatile LAS unsigned*)(lds + MISC_OFF);
    const int tid0 = threadIdx.x, wave = __builtin_amdgcn_readfirstlane(tid0 >> 6);
#define FRESH_IDS() int tid = tid0; asm volatile("" : "+v"(tid)); const int lane = tid & 63; (void)lane
    const int G = gridDim.x; const int bx = blockIdx.x; const int vcu = (G % 8 == 0) ? (bx % 8) * (G / 8) + bx / 8 : bx;
    unsigned char* ws = args.ws;
    gu32* ctl = (gu32*)(ws + WS_CTL);
    { FRESH_IDS(); for (int u = tid; u < (LDS_BYTES - LDSCTL_OFF) / 4; u += NWAVES * 64) ((LAS unsigned*)(lds + LDSCTL_OFF))[u] = 0u; }
    __syncthreads();
    XcdBarrier bar = xcd_barrier_post((unsigned*)(ctl + CW_BAR) + args.li * XCD_BAR_WORDS, MISC + 8);
    const int lo = args.ph_lo, hi = args.ph_hi;
#define IN(k) (lo <= (k) && (k) < hi)
#define BOTH(k) (IN(k) && IN((k) + 1))
#define GRID_BAR() xcd_barrier(bar)
    const float* x = args.in[0];
    bf16* XB = (bf16*)(ws + WS_XB); float* rstd1 = (float*)(ws + WS_RSTD1); float* rope = (float*)(ws + WS_ROPE);
    bf16* Win_t = (bf16*)(ws + WS_WIN);

    if (IN(PH_PROLOGUE)) { FRESH_IDS();
        LAS float* scr = (LAS float*)(lds + RING_OFF + wave * 16384);
        const int gw = vcu * NWAVES + wave, NGW = G * NWAVES;
        {
            int base = 0;
            for (int jb = 0; jb < N_TRJOBS; ++jb) { const TrJob t = p0_job(args, jb); const int per = (t.K / 64) * (t.N / 32), tot = per * t.nmat;
                int first = gw - (base % NGW); if (first < 0) first += NGW;
                for (int it = first; it < tot; it += NGW) { const int mi = it / per, sub = it - mi * per;
                    p0_transpose_item(t.W + (size_t)mi * t.K * t.N, t.K, t.N, t.gain, t.WT, t.ldt, t.row_off + mi * t.rows_per_mat, t.mode, scr, sub, lane); }
                base += tot; }
            bf16* wr = (bf16*)(ws + WS_WROUTER); int* ident = (int*)(ws + WS_IDENT);
            for (int e = vcu * (NWAVES * 64) + tid; e < N_EXP * D_MODEL; e += G * NWAVES * 64) { const int ex = e >> 10, k = e & 1023; const float v = args.in[20][(size_t)k * N_EXP + ex] * args.in[19][k];
                const bf16 hi = f2bf(v); wr[(size_t)ex * D_MODEL + k] = hi; wr[(size_t)(64 + ex) * D_MODEL + k] = f2bf(v - bf2f(hi)); }
            for (int e = vcu * (NWAVES * 64) + tid; e < NTOK; e += G * NWAVES * 64) ident[e] = e;
        }
        for (int m = gw; m < NTOK; m += 4 * NGW) rows_pass<4, 0>(x, XB, rstd1, nullptr, m, NGW, lane);
        static_assert(NTOK % (4 * 256 * NWAVES) == 0, "row pass unroll");
        { const SsmIn SP{args.in[7], args.in[8], args.in[9], args.in[10], args.in[11], args.in[12], args.in[13], args.in[14]};
          bf16* btcat = (bf16*)(ws + WS_BTCAT); bf16* btst = (bf16*)(ws + WS_BTST);
          for (int it = NGW - 1 - gw; it < SSM_ITEMS; it += NGW) {
              if (it < SSM_I_TOEP) ssm_item_toep(SP, btcat, scr, it, lane);
              else if (it < SSM_I_TOEP + SSM_I_OUT) ssm_item_out(SP, btcat, it - SSM_I_TOEP, lane);
              else ssm_item_state(SP, btst, it - SSM_I_TOEP - SSM_I_OUT, lane); } }
        if (bx == 0) for (int e = tid; e < 64 * 16; e += NWAVES * 64) { const int coord = e >> 4, i = e & 15; const float invf = powf(10000.f, -(float)(2 * i) / 32.f);
            rope[2 * e] = cosf((float)coord * invf); rope[2 * e + 1] = sinf((float)coord * invf); }
        if (BOTH(PH_PROLOGUE)) GRID_BAR();
    }
    if (IN(PH_INPROJ)) { FRESH_IDS();
        LAS float* rope_l = (LAS float*)(lds + LDS_ROPE_OFF);
        for (int e = tid; e < 64 * 16 * 2 / 4; e += NWAVES * 64) ((LAS f32x4*)rope_l)[e] = ((const f32x4*)rope)[e];
        __syncthreads();
        pg8::Desc g{D_MODEL, D_MODEL * 2, D_MODEL * 2};
        pg8::PlainOrder S{(const char*)XB, (const char*)Win_t, NTOK / 256, IN_W / 256, G, bx, D_MODEL * 2, D_MODEL * 2};
        EpiInProj E{rstd1, rope_l, args.in[4], args.in[5], (bf16*)(ws + WS_Q), (bf16*)(ws + WS_K), (bf16*)(ws + WS_V), (bf16*)(ws + WS_UCAT), (bf16*)(ws + WS_GA), (bf16*)(ws + WS_GS)};
        pg8::gemm_run<EpiInProj, pg8::PlainOrder, true, false>(lds + RING_OFF, g, S, E);
        if (BOTH(PH_INPROJ)) GRID_BAR();
    }
    if (IN(PH_SSTATE)) {
        pg8::Desc g{1024, UCAT_LD * 2, 2048};
        StateOrder S{(const char*)(ws + WS_UCAT), (const char*)(ws + WS_BTST), G, bx};
        EpiState E{(float*)(ws + WS_LST)};
        pg8::gemm_run<EpiState, StateOrder, true, false>(lds + RING_OFF, g, S, E);
        if (BOTH(PH_SSTATE)) GRID_BAR();
    }
    if (IN(PH_SCARRY)) { FRESH_IDS();
        const SsmIn SP{args.in[7], args.in[8], args.in[9], args.in[10], args.in[11], args.in[12], args.in[13], args.in[14]};
        for (int idx = vcu * (NWAVES * 64) + tid; idx < SSM_NG * BATCH * 2 * SSM_P; idx += G * NWAVES * 64) ssm_carry(SP, (const float*)(ws + WS_LST), (bf16*)(ws + WS_UCAT), idx);
        if (BOTH(PH_SCARRY)) GRID_BAR();
    }
    if (IN(PH_ATTN)) {
        static_assert(attn_body::ATTN_LDS_BYTES <= RING_BYTES, "attention scratch vs ring");
        const attn_body::AttnTensors AT{(const attn_body::bf16*)(ws + WS_Q), (const attn_body::bf16*)(ws + WS_K), (const attn_body::bf16*)(ws + WS_V), (attn_body::bf16*)(ws + WS_O)};
        const attn_body::StaticOrder S(G, vcu);
        { pg8::Desc g{UCAT_LD, UCAT_LD * 2, UCAT_LD * 2};
          YOrder SY{(const char*)(ws + WS_UCAT), (const char*)(ws + WS_BTCAT), G, bx};
          EpiY EY{(bf16*)(ws + WS_YACT)};
          pg8::gemm_run<EpiY, YOrder, true, false>(lds + RING_OFF, g, SY, EY); }
        attn_body::attn_phase<attn_body::StaticOrder>((char*)lds_raw + RING_OFF, AT, S);
        if (BOTH(PH_ATTN)) GRID_BAR();
    }
    if (IN(PH_GLU)) {
        pg8::Desc g{SSM_W, SSM_W * 2, SSM_W * 2};
        pg8::PlainOrder S{(const char*)(ws + WS_YACT), (const char*)(ws + WS_WGLU), NTOK / 256, 1, G, bx, SSM_W * 2, SSM_W * 2};
        EpiGlu E{(bf16*)(ws + WS_YACT), args.in[16]};
        pg8::gemm_run<EpiGlu, pg8::PlainOrder, true, false>(lds + RING_OFF, g, S, E);
        if (BOTH(PH_GLU)) GRID_BAR();
    }
    if (IN(PH_MERGE_A)) {
        pg8::Desc g{Q_W, Q_W * 2, Q_W * 2};
        pg8::PlainOrder S{(const char*)(ws + WS_O), (const char*)(ws + WS_WAU), NTOK / 256, D_MODEL / 256, G, bx, Q_W * 2, Q_W * 2};
        EpiMerge<true> E{(bf16*)(ws + WS_GA), (const bf16*)(ws + WS_GA)};
        pg8::gemm_run<EpiMerge<true>, pg8::PlainOrder, true, false>(lds + RING_OFF, g, S, E);
        if (BOTH(PH_MERGE_A)) GRID_BAR();
    }
    if (IN(PH_MERGE_B)) {
        pg8::Desc g{SSM_W, SSM_W * 2, SSM_W * 2};
        pg8::PlainOrder S{(const char*)(ws + WS_YACT), (const char*)(ws + WS_WSU), NTOK / 256, D_MODEL / 256, G, bx, SSM_W * 2, SSM_W * 2};
        EpiMerge<false> E{(bf16*)(ws + WS_GA), (const bf16*)(ws + WS_GS)};
        pg8::gemm_run<EpiMerge<false>, pg8::PlainOrder, true, false>(lds + RING_OFF, g, S, E);
        if (BOTH(PH_MERGE_B)) GRID_BAR();
    }
    if (IN(PH_OUTPROJ)) {
        pg8::Desc g{D_MODEL, D_MODEL * 2, D_MODEL * 2};
        pg8::PlainOrder S{(const char*)(ws + WS_GA), (const char*)(ws + WS_WOUT), NTOK / 256, D_MODEL / 256, G, bx, D_MODEL * 2, D_MODEL * 2};
        EpiResid E{x, args.out};
        pg8::gemm_run<EpiResid, pg8::PlainOrder, true, false>(lds + RING_OFF, g, S, E);
        if (BOTH(PH_OUTPROJ)) GRID_BAR();
    }
    MoeBufs MB; MB.xn2 = (bf16*)(ws + WS_XN2); MB.logit = (float*)(ws + WS_LOGIT); MB.cnt = (int*)(ws + WS_CTL) + CW_CNT; MB.list_tok = (int*)(ws + WS_LTOK); MB.list_w = (float*)(ws + WS_LW);
    MB.slot_e = (int*)(ws + WS_LROW); MB.slot_lp = (int*)(ws + WS_LROW + 4 * MiB); MB.ident = (const int*)(ws + WS_IDENT); MB.hid = (bf16*)(ws + WS_HID); MB.hsh = (bf16*)(ws + WS_HSH); MB.yslot = (unsigned char*)(ws + WS_YSLOT); MB.ysh = (bf16*)(ws + WS_XN2);
    LAS int* tab = (LAS int*)(lds + LDS_TAB_OFF);
    if (IN(PH_ROUTE)) { FRESH_IDS();
        for (int rt = bx; rt < NTOK / 256; rt += G)
            for (int i = 0; i < 32; i += 4) rows_pass<4, 1>(args.out, MB.xn2, nullptr, nullptr, rt * 256 + wave * 32 + i, 1, lane);
        VM_WAIT(); __syncthreads();
        { pg8::Desc g{D_MODEL, D_MODEL * 2, D_MODEL * 2};
          OneTileOrder S{(const char*)MB.xn2, (const char*)(ws + WS_WROUTER), G, bx, NTOK / 256, D_MODEL * 2};
          EpiRouter E{MB.logit};
          pg8::gemm_run<EpiRouter, OneTileOrder, false, false>(lds + RING_OFF, g, S, E); }
        VM_WAIT(); __syncthreads();
        for (int rt = bx; rt < NTOK / 256; rt += G) {
            if (tid < 64) { tab[256 + tid] = 0; tab[384 + tid] = 0; }
            __syncthreads();
            int idx[8]; float wgt[8]; const int t = rt * 256 + tid;
            if (tid < 256) { route_token(MB.logit + (size_t)t * 128, args.in[21], idx, wgt);
#pragma unroll
                for (int k = 0; k < TOP_K; ++k) __hip_atomic_fetch_add(tab + 256 + idx[k], 1, __ATOMIC_RELAXED, __HIP_MEMORY_SCOPE_WORKGROUP); }
            __syncthreads();
            if (tid < 64) tab[320 + tid] = __hip_atomic_fetch_add(MB.cnt + tid, tab[256 + tid], __ATOMIC_RELAXED, __HIP_MEMORY_SCOPE_AGENT);
            __syncthreads();
            if (tid < 256) {
#pragma unroll
                for (int k = 0; k < TOP_K; ++k) { const int e = idx[k]; const int lp = tab[320 + e] + __hip_atomic_fetch_add(tab + 384 + e, 1, __ATOMIC_RELAXED, __HIP_MEMORY_SCOPE_WORKGROUP);
                    const size_t o = (size_t)e * EXP_CAP + lp; MB.list_tok[o] = t; MB.list_w[o] = wgt[k]; MB.slot_e[t * TOP_K + k] = e; MB.slot_lp[t * TOP_K + k] = lp; } }
            __syncthreads();
        }
        if (BOTH(PH_ROUTE)) GRID_BAR();
    }
    if (IN(PH_EXP_GU)) { FRESH_IDS();
        moe_build_tab(tab, MB.cnt, tid);
        pg8::Desc g{D_MODEL, D_MODEL * 2, D_MODEL * 2};
        GuOrder S{tab, (const char*)MB.xn2, (const char*)(ws + WS_WEGU), (const char*)(ws + WS_WSGU), MB.list_tok, MB.ident, G, bx};
        EpiGu E{MB.hid, MB.hsh, MB.list_w};
        pg8::gemm_run<EpiGu, GuOrder, true, true>(lds + RING_OFF, g, S, E);
        if (BOTH(PH_EXP_GU)) GRID_BAR();
    }
    if (IN(PH_DOWN)) { FRESH_IDS();
        moe_build_tab(tab, MB.cnt, tid);
        { pg8::Desc g{EXP_D, EXP_D * 2, EXP_D * 2};
          DownOrder S{tab, (const char*)MB.hid, (const char*)(ws + WS_WED), G, bx};
          EpiFp8Store E{MB.yslot};
          pg8::gemm_run<EpiFp8Store, DownOrder, true, false>(lds + RING_OFF, g, S, E); }
        { pg8::Desc g{SH_D, SH_D * 2, SH_D * 2};
          pg8::PlainOrder S{(const char*)MB.hsh, (const char*)(ws + WS_WSD), NTOK / 256, D_MODEL / 256, G, bx, SH_D * 2, SH_D * 2};
          EpiBf16Store E{MB.ysh, D_MODEL};
          pg8::gemm_run<EpiBf16Store, pg8::PlainOrder, true, false>(lds + RING_OFF, g, S, E); }
        if (BOTH(PH_DOWN)) GRID_BAR();
    }
    if (IN(PH_COMB)) { FRESH_IDS();
        const int gw = vcu * NWAVES + wave, NGW = G * NWAVES;
        moe_build_tab(tab, MB.cnt, tid);
        for (int t = gw; t < NTOK; t += NGW) moe_combine_row(args.out + (size_t)t * D_MODEL, MB.ysh + (size_t)t * D_MODEL, MB.yslot, MB.slot_e + (size_t)t * TOP_K, MB.slot_lp + (size_t)t * TOP_K, tab, lane);
        bf16* pb = (bf16*)(ws + WS_HID);
        for (int t = gw; t < NTOK; t += 8 * NGW) { f32x4 v[8];
#pragma unroll
            for (int q = 0; q < 8; ++q) v[q] = *((const GAS f32x4*)(args.in[1] + (size_t)(t + q * NGW) * PLE_D) + lane);
#pragma unroll
            for (int q = 0; q < 8; ++q) *((GAS v2u*)(pb + (size_t)(t + q * NGW) * PLE_D) + lane) = (v2u){cvt_pk_bf16(v[q].x, v[q].y), cvt_pk_bf16(v[q].z, v[q].w)}; }
        if (BOTH(PH_COMB)) GRID_BAR();
    }
    if (IN(PH_PLE_PP)) {
        pg8::Desc g{PLE_D, PLE_D * 2, PLE_D * 2};
        pg8::PlainOrder S{(const char*)(ws + WS_HID), (const char*)(ws + WS_WPP), NTOK / 256, D_MODEL / 256, G, bx, PLE_D * 2, PLE_D * 2};
        EpiBf16Store E{(bf16*)(ws + WS_YSLOT), D_MODEL};
        pg8::gemm_run<EpiBf16Store, pg8::PlainOrder, true, false>(lds + RING_OFF, g, S, E);
        if (BOTH(PH_PLE_PP)) GRID_BAR();
    }
    if (IN(PH_PLE_GATE)) {
        pg8::Desc g{D_MODEL, D_MODEL * 2, D_MODEL * 2};
        pg8::PlainOrder S{(const char*)(ws + WS_XN3), (const char*)(ws + WS_WPG), NTOK / 256, D_MODEL / 256, G, bx, D_MODEL * 2, D_MODEL * 2};
        EpiPle E{args.out, (const bf16*)(ws + WS_YSLOT)};
        pg8::gemm_run<EpiPle, pg8::PlainOrder, true, false>(lds + RING_OFF, g, S, E);
        if (BOTH(PH_PLE_GATE)) GRID_BAR();
    }
    if (IN(PH_FINAL)) { FRESH_IDS();
        const int gw = vcu * NWAVES + wave, NGW = G * NWAVES;
        for (int t = gw; t < NTOK; t += 4 * NGW) rows_pass<4, 2>(args.out, nullptr, args.out, args.in[31], t, NGW, lane);
    }
#undef IN
#undef BOTH
#undef GRID_BAR
}
template <class AL, class EP>
__global__ void __launch_bounds__(256) ngemm(AL al, EP ep, const int* Mz, const float* __restrict__ B, size_t strideB, int M, int N, int K, int ldb) {
    __shared__ float As[16][68];
    __shared__ float Bs[16][68];
    const int z = blockIdx.z;
    const int Mv = Mz ? Mz[z] : M;
    const int r0 = blockIdx.y * 64, c0 = blockIdx.x * 64;
    if (r0 >= Mv) return;
    const float* Bz = B + (size_t)z * strideB;
    const int tid = threadIdx.x, tx = tid & 15, ty = tid >> 4;
    float acc[4][4];
#pragma unroll
    for (int i = 0; i < 4; ++i)
#pragma unroll
        for (int j = 0; j < 4; ++j) acc[i][j] = 0.f;
    for (int k0 = 0; k0 < K; k0 += 16) {
#pragma unroll
        for (int i = 0; i < 4; ++i) {
            const int e = tid + i * 256, kk = e & 15, rr = e >> 4;
            const int r = r0 + rr;
            As[kk][rr] = (r < Mv) ? al.a(z, r, k0 + kk) : 0.f;
        }
#pragma unroll
        for (int i = 0; i < 4; ++i) {
            const int e = tid + i * 256, cc = e & 63, kk = e >> 6;
            Bs[kk][cc] = Bz[(size_t)(k0 + kk) * ldb + c0 + cc];
        }
        __syncthreads();
#pragma unroll
        for (int kk = 0; kk < 16; ++kk) {
            float a[4], b[4];
#pragma unroll
            for (int i = 0; i < 4; ++i) { a[i] = As[kk][ty * 4 + i]; b[i] = Bs[kk][tx * 4 + i]; }
#pragma unroll
            for (int i = 0; i < 4; ++i)
#pragma unroll
                for (int j = 0; j < 4; ++j) acc[i][j] += a[i] * b[j];
        }
        __syncthreads();
    }
#pragma unroll
    for (int i = 0; i < 4; ++i) {
        const int r = r0 + ty * 4 + i;
        if (r < Mv) {
#pragma unroll
            for (int j = 0; j < 4; ++j) ep.put(z, r, c0 + tx * 4 + j, acc[i][j]);
        }
    }
}
template <class AL, class EP>
static void launch_ngemm(hipStream_t s, int M, const int* Mz, int Mmax, int N, int K, int Z, AL al, const float* B, size_t strideB, int ldb, EP ep) {
    dim3 g(N / 64, (Mmax + 63) / 64, Z);
    hipLaunchKernelGGL((ngemm<AL, EP>), g, dim3(256), 0, s, al, ep, Mz, B, strideB, M, N, K, ldb);
}

struct AL_f32 { const float* A; int lda; int pad; __device__ float a(int, int r, int k) const { return A[(size_t)r * lda + k]; } };
struct AL_f32g { const float* A; const float* g; int lda; int pad; __device__ float a(int, int r, int k) const { return A[(size_t)r * lda + k] * g[k]; } };
struct AL_bf16 { const bf16* A; int lda; int pad; __device__ float a(int, int r, int k) const { return bf2f(A[(size_t)r * lda + k]); } };
struct AL_gather { const float* A; const int* list; int lda; int cap; __device__ float a(int z, int r, int k) const { return A[(size_t)list[(size_t)z * cap + r] * lda + k]; } };
struct AL_slot { const float* A; const int* base; int lda; int pad; __device__ float a(int z, int r, int k) const { return A[(size_t)(base[z] + r) * lda + k]; } };

__global__ void __launch_bounds__(256) k_rstd(const float* __restrict__ x, float* __restrict__ rstd, int rows) {
    const int row = blockIdx.x * 4 + (threadIdx.x >> 6), lane = threadIdx.x & 63;
    if (row >= rows) return;
    const float4* xr = (const float4*)(x + (size_t)row * D_MODEL);
    float s = 0.f;
#pragma unroll
    for (int j = 0; j < 4; ++j) { const float4 v = xr[lane + 64 * j]; s += v.x * v.x + v.y * v.y + v.z * v.z + v.w * v.w; }
    s = wave_sum(s);
    if (lane == 0) rstd[row] = rsqrtf(s * (1.f / D_MODEL) + EPS);
}
__global__ void __launch_bounds__(256) k_rownorm_f32(const float* __restrict__ x, const float* __restrict__ g, float* __restrict__ out, int rows) {
    const int row = blockIdx.x * 4 + (threadIdx.x >> 6), lane = threadIdx.x & 63;
    if (row >= rows) return;
    const float4* xr = (const float4*)(x + (size_t)row * D_MODEL);
    float4 v[4]; float s = 0.f;
#pragma unroll
    for (int j = 0; j < 4; ++j) { v[j] = xr[lane + 64 * j]; s += v[j].x * v[j].x + v[j].y * v[j].y + v[j].z * v[j].z + v[j].w * v[j].w; }
    const float r = rsqrtf(wave_sum(s) * (1.f / D_MODEL) + EPS);
    float4* o = (float4*)(out + (size_t)row * D_MODEL);
#pragma unroll
    for (int j = 0; j < 4; ++j) { const float4 gg = ((const float4*)g)[lane + 64 * j]; o[lane + 64 * j] = make_float4(v[j].x * r * gg.x, v[j].y * r * gg.y, v[j].z * r * gg.z, v[j].w * r * gg.w); }
}
__global__ void __launch_bounds__(256) k_combine(float* __restrict__ h, const float* __restrict__ acc, bf16* __restrict__ xn3, int rows) {
    const int row = blockIdx.x * 4 + (threadIdx.x >> 6), lane = threadIdx.x & 63;
    if (row >= rows) return;
    float4* hr = (float4*)(h + (size_t)row * D_MODEL);
    const float4* ar = (const float4*)(acc + (size_t)row * D_MODEL);
    float4 v[4]; float s = 0.f;
#pragma unroll
    for (int j = 0; j < 4; ++j) { const float4 a = hr[lane + 64 * j], b = ar[lane + 64 * j]; v[j] = make_float4(a.x + b.x, a.y + b.y, a.z + b.z, a.w + b.w);
        s += v[j].x * v[j].x + v[j].y * v[j].y + v[j].z * v[j].z + v[j].w * v[j].w; }
    const float r = rsqrtf(wave_sum(s) * (1.f / D_MODEL) + EPS);
#pragma unroll
    for (int j = 0; j < 4; ++j) { hr[lane + 64 * j] = v[j];
        bf16* o = xn3 + (size_t)row * D_MODEL + (lane + 64 * j) * 4;
        o[0] = f2bf(v[j].x * r); o[1] = f2bf(v[j].y * r); o[2] = f2bf(v[j].z * r); o[3] = f2bf(v[j].w * r); }
}

struct EP_inproj { const float* rstd; float* qk; bf16* V; bf16* ucat; bf16* ga; bf16* gs;
    __device__ void put(int, int r, int c, float acc) const {
        const float v = acc * rstd[r];
        if (c < 640) qk[(size_t)r * 640 + c] = v;
        else if (c < 768) V[(size_t)r * KV_W + (c - 640)] = f2bf(v);
        else if (c < 1024) { const int cu = c - 768, g = cu >> 4, ch = cu & 15, b = r / SEQ, t = r % SEQ;
            ucat[((size_t)g * (BATCH * NCHUNK) + b * NCHUNK + t / CH_T) * UCAT_LD + (t % CH_T) * SSM_G + ch] = f2bf(v); }
        else if (c < 2048) ga[(size_t)r * D_MODEL + (c - 1024)] = f2bf(sigmoidf_(v));
        else gs[(size_t)r * D_MODEL + (c - 2048)] = f2bf(sigmoidf_(v));
    } };
__global__ void __launch_bounds__(256) k_qknorm(const float* __restrict__ qk, const float* __restrict__ qn, const float* __restrict__ kn, bf16* __restrict__ Q, bf16* __restrict__ K) {
    const int idx = blockIdx.x * 256 + threadIdx.x;
    if (idx >= NTOK * 10) return;
    const int r = idx / 10, j = idx % 10;
    const float* src = qk + (size_t)r * 640 + j * 64;
    float y[64]; float s = 0.f;
#pragma unroll
    for (int d = 0; d < 64; ++d) { y[d] = src[d]; s += y[d] * y[d]; }
    const float rs = rsqrtf(s * (1.f / 64.f) + EPS);
    const float* w = (j < 8) ? qn : kn;
#pragma unroll
    for (int d = 0; d < 64; ++d) y[d] = y[d] * rs * w[d];
    const int pos = r % SEQ; const float row = (float)(pos / 64), col = (float)(pos % 64);
    float o[64];
#pragma unroll
    for (int i = 0; i < 16; ++i) {
        const float invf = powf(10000.f, -(float)(2 * i) / 32.f);
        float sr, cr, sc, cc; sincosf(row * invf, &sr, &cr); sincosf(col * invf, &sc, &cc);
        o[i] = y[i] * cr - y[i + 16] * sr; o[i + 16] = y[i + 16] * cr + y[i] * sr;
        o[32 + i] = y[32 + i] * cc - y[48 + i] * sc; o[48 + i] = y[48 + i] * cc + y[32 + i] * sc;
    }
    if (j < 8) { bf16* dst = Q + (size_t)r * Q_W + j * 64;
#pragma unroll
        for (int d = 0; d < 64; ++d) dst[d] = f2bf(o[d] * C2); }
    else { bf16* dst = K + (size_t)r * KV_W + (j - 8) * 64;
#pragma unroll
        for (int d = 0; d < 64; ++d) dst[d] = f2bf(o[d]); }
}

__global__ void __launch_bounds__(256) k_attn_naive(const bf16* __restrict__ Q, const bf16* __restrict__ K, const bf16* __restrict__ V, bf16* __restrict__ O) {
    const int qb = blockIdx.x & 7, h = (blockIdx.x >> 3) & 7, b = blockIdx.x >> 6;
    const int r = b * SEQ + qb * 256 + threadIdx.x, kvh = h / (N_HEADS / N_KV);
    float q[64], o[64];
#pragma unroll
    for (int d = 0; d < 64; ++d) { q[d] = bf2f(Q[(size_t)r * Q_W + h * 64 + d]); o[d] = 0.f; }
    float m = -INFINITY, l = 0.f;
    const bf16* Kb = K + (size_t)b * SEQ * KV_W + kvh * 64; const bf16* Vb = V + (size_t)b * SEQ * KV_W + kvh * 64;
    for (int j = 0; j < SEQ; ++j) {
        const bf16* kr = Kb + (size_t)j * KV_W; const bf16* vr = Vb + (size_t)j * KV_W;
        float s = 0.f;
#pragma unroll
        for (int d = 0; d < 64; ++d) s += q[d] * bf2f(kr[d]);
        if (s > m) { const float sc = exp2f(m - s); l *= sc;
#pragma unroll
            for (int d = 0; d < 64; ++d) o[d] *= sc;
            m = s; }
        const float p = exp2f(s - m); l += p;
#pragma unroll
        for (int d = 0; d < 64; ++d) o[d] += p * bf2f(vr[d]);
    }
    const float il = 1.f / l;
#pragma unroll
    for (int d = 0; d < 64; ++d) O[(size_t)r * Q_W + h * 64 + d] = f2bf(o[d] * il);
}

__global__ void __launch_bounds__(64) k_ssm_naive(const bf16* __restrict__ ucat, const float* __restrict__ a_re, const float* __restrict__ a_im, const float* __restrict__ log_dt,
                                                  const float* __restrict__ b_re, const float* __restrict__ b_im, const float* __restrict__ c_re, const float* __restrict__ c_im,
                                                  const float* __restrict__ d_skip, float* __restrict__ ytmp, bf16* __restrict__ yact) {
    const int g = blockIdx.x & 15, b = blockIdx.x >> 4, p = threadIdx.x;
    for (int dir = 0; dir < 2; ++dir) {
        const int gi = dir * SSM_NG + g;
        const float are = a_re[gi * SSM_P + p], aim = a_im[gi * SSM_P + p], dt = expf(log_dt[gi]);
        const float mag = expf(are * dt); float sn, cs; sincosf(aim * dt, &sn, &cs);
        const float abr = mag * cs, abi = mag * sn;
        const float nr = abr - 1.f, ni = abi, den = are * are + aim * aim;
        const float cfr = (nr * are + ni * aim) / den, cfi = (ni * are - nr * aim) / den;
        float bbr[16], bbi[16], cr[16], ci[16];
#pragma unroll
        for (int c = 0; c < 16; ++c) {
            const float br = b_re[((size_t)gi * SSM_P + p) * SSM_G + c], bi = b_im[((size_t)gi * SSM_P + p) * SSM_G + c];
            bbr[c] = cfr * br - cfi * bi; bbi[c] = cfr * bi + cfi * br;
            cr[c] = c_re[((size_t)gi * SSM_G + c) * SSM_P + p]; ci[c] = c_im[((size_t)gi * SSM_G + c) * SSM_P + p];
        }
        float sr = 0.f, si = 0.f;
        for (int tt = 0; tt < SEQ; ++tt) {
            const int t = dir ? (SEQ - 1 - tt) : tt;
            const bf16* up = ucat + ((size_t)g * (BATCH * NCHUNK) + b * NCHUNK + t / CH_T) * UCAT_LD + (t % CH_T) * SSM_G;
            float u[16]; float bur = 0.f, bui = 0.f;
#pragma unroll
            for (int c = 0; c < 16; ++c) { u[c] = bf2f(up[c]); bur += bbr[c] * u[c]; bui += bbi[c] * u[c]; }
            const float nsr = abr * sr - abi * si + bur, nsi = abr * si + abi * sr + bui; sr = nsr; si = nsi;
            float mine = 0.f;
#pragma unroll
            for (int c = 0; c < 16; ++c) { const float v = wave_sum(cr[c] * sr - ci[c] * si); if (p == c) mine = v; }
            if (p < 16) {
                const size_t oi = ((size_t)b * SEQ + t) * SSM_W + g * SSM_G + p;
                float up_ = 0.f;
#pragma unroll
                for (int c = 0; c < 16; ++c) if (p == c) up_ = u[c];
                if (dir == 0) ytmp[oi] = mine + d_skip[g * SSM_G + p] * up_;
                else yact[oi] = f2bf(gelu_tanh(ytmp[oi] + mine));
            }
        }
    }
}

struct EP_glu { const bf16* yact; const float* bglu; float* ssm; int row0; int pad;
    __device__ void put(int, int r, int c, float acc) const { const float y = bf2f(yact[(size_t)(row0 + r) * SSM_W + c]); ssm[(size_t)r * SSM_W + c] = y * sigmoidf_(acc + bglu[c]); } };
struct EP_gate_set { const bf16* gate; float* t; int row0; int pad;
    __device__ void put(int, int r, int c, float acc) const { t[(size_t)r * D_MODEL + c] = bf2f(gate[(size_t)(row0 + r) * D_MODEL + c]) * acc; } };
struct EP_gate_add { const bf16* gate; float* t; int row0; int pad;
    __device__ void put(int, int r, int c, float acc) const { t[(size_t)r * D_MODEL + c] += bf2f(gate[(size_t)(row0 + r) * D_MODEL + c]) * acc; } };
struct EP_resid { const float* x; float* out;
    __device__ void put(int, int r, int c, float acc) const { out[(size_t)r * D_MODEL + c] = x[(size_t)r * D_MODEL + c] + acc; } };

struct EP_sigmoid { float* o; int ld; int pad; __device__ void put(int, int r, int c, float acc) const { o[(size_t)r * ld + c] = sigmoidf_(acc); } };
struct EP_store { float* o; int ld; int pad; __device__ void put(int, int r, int c, float acc) const { o[(size_t)r * ld + c] = acc; } };
struct EP_add { float* o; int ld; int pad; __device__ void put(int, int r, int c, float acc) const { o[(size_t)r * ld + c] += acc; } };
struct EP_silu_mul { const float* g; float* o; int ld; int pad; __device__ void put(int, int r, int c, float acc) const { const float gv = g[(size_t)r * ld + c]; o[(size_t)r * ld + c] = gv * sigmoidf_(gv) * acc; } };
struct EP_slot_store { float* o; const int* base; __device__ void put(int z, int r, int c, float acc) const { o[(size_t)(base[z] + r) * EXP_D + c] = acc; } };
struct EP_slot_silu { float* o; const int* base; const float* w; int cap; int pad;
    __device__ void put(int z, int r, int c, float acc) const { float* e = o + (size_t)(base[z] + r) * EXP_D + c; const float gv = *e; *e = gv * sigmoidf_(gv) * acc * w[(size_t)z * cap + r]; } };
struct EP_scatter_add { float* acc_; const int* list; int cap; int pad;
    __device__ void put(int z, int r, int c, float acc) const { atomicAdd(acc_ + (size_t)list[(size_t)z * cap + r] * D_MODEL + c, acc); } };

__global__ void __launch_bounds__(256) k_route(const float* __restrict__ scores, const float* __restrict__ rbias, int* __restrict__ cnt, int* __restrict__ list, float* __restrict__ listw, int rows, int cap) {
    const int t = blockIdx.x * 256 + threadIdx.x;
    if (t >= rows) return;
    float s[64], bsd[64];
#pragma unroll
    for (int e = 0; e < 64; ++e) { s[e] = scores[(size_t)t * 64 + e]; bsd[e] = s[e] + rbias[e]; }
    float gs[8];
#pragma unroll
    for (int g = 0; g < 8; ++g) { float m1 = -INFINITY, m2 = -INFINITY;
#pragma unroll
        for (int j = 0; j < 8; ++j) { const float v = bsd[g * 8 + j]; if (v > m1) { m2 = m1; m1 = v; } else if (v > m2) m2 = v; }
        gs[g] = m1 + m2; }
    unsigned gmask = 0;
#pragma unroll
    for (int k = 0; k < TOPK_G; ++k) { int best = -1; float bv = -INFINITY;
#pragma unroll
        for (int g = 0; g < 8; ++g) if (!((gmask >> g) & 1u) && gs[g] > bv) { bv = gs[g]; best = g; }
        gmask |= 1u << best; }
    unsigned long long emask = 0ull; int idx[8]; float wsum = 0.f;
#pragma unroll
    for (int k = 0; k < TOP_K; ++k) { int best = -1; float bv = -INFINITY;
#pragma unroll
        for (int e = 0; e < 64; ++e) { const bool ok = ((gmask >> (e >> 3)) & 1u) && !((emask >> e) & 1ull); if (ok && bsd[e] > bv) { bv = bsd[e]; best = e; } }
        emask |= 1ull << best; idx[k] = best; }
#pragma unroll
    for (int k = 0; k < 8; ++k) { float sv = 0.f;
#pragma unroll
        for (int e = 0; e < 64; ++e) if (e == idx[k]) sv = s[e];
        wsum += sv; }
#pragma unroll
    for (int k = 0; k < 8; ++k) { float sv = 0.f;
#pragma unroll
        for (int e = 0; e < 64; ++e) if (e == idx[k]) sv = s[e];
        const int e = idx[k]; const int pos = atomicAdd(cnt + e, 1);
        list[(size_t)e * cap + pos] = t; listw[(size_t)e * cap + pos] = sv / wsum * ROUTED_SCALE; }
}
__global__ void k_prefix(const int* __restrict__ cnt, int* __restrict__ base) { if (threadIdx.x == 0) { int s = 0; for (int e = 0; e < 64; ++e) { base[e] = s; s += cnt[e]; } } }

struct EP_ple { float* h; const float* pp;
    __device__ void put(int, int r, int c, float acc) const { float* e = h + (size_t)r * D_MODEL + c; *e = *e + sigmoidf_(acc) * pp[(size_t)r * D_MODEL + c]; } };
__global__ void __launch_bounds__(256) k_final(float* __restrict__ h, const float* __restrict__ g, int rows) {
    const int row = blockIdx.x * 4 + (threadIdx.x >> 6), lane = threadIdx.x & 63;
    if (row >= rows) return;
    float4* hr = (float4*)(h + (size_t)row * D_MODEL);
    float4 v[4]; float s = 0.f;
#pragma unroll
    for (int j = 0; j < 4; ++j) { v[j] = hr[lane + 64 * j]; s += v[j].x * v[j].x + v[j].y * v[j].y + v[j].z * v[j].z + v[j].w * v[j].w; }
    const float r = rsqrtf(wave_sum(s) * (1.f / D_MODEL) + EPS);
#pragma unroll
    for (int j = 0; j < 4; ++j) { const float4 gg = ((const float4*)g)[lane + 64 * j]; hr[lane + 64 * j] = make_float4(v[j].x * r * gg.x, v[j].y * r * gg.y, v[j].z * r * gg.z, v[j].w * r * gg.w); }
}

__global__ void __launch_bounds__(256) k_naive_winT(const float* __restrict__ w, const float* __restrict__ g, bf16* __restrict__ wt) {
    const size_t idx = (size_t)blockIdx.x * 256 + threadIdx.x;
    if (idx >= (size_t)IN_W * D_MODEL) return;
    const int n = (int)(idx / D_MODEL), k = (int)(idx % D_MODEL);
    wt[(size_t)inproj_phys(n) * D_MODEL + k] = f2bf(w[(size_t)k * IN_W + n] * g[k]);
}
__global__ void __launch_bounds__(256) k_naive_xb(const float* __restrict__ x, bf16* __restrict__ xb) {
    const size_t idx = (size_t)blockIdx.x * 256 + threadIdx.x;
    if (idx < (size_t)NTOK * D_MODEL) xb[idx] = f2bf(x[idx]);
}
__global__ void __launch_bounds__(256) k_naive_rope(float* __restrict__ rope) {
    const int e = blockIdx.x * 256 + threadIdx.x; if (e >= 1024) return;
    const int coord = e >> 4, i = e & 15; const float invf = powf(10000.f, -(float)(2 * i) / 32.f);
    rope[2 * e] = cosf((float)coord * invf); rope[2 * e + 1] = sinf((float)coord * invf);
}
__global__ void __launch_bounds__(256) k_dbg_cmp(const unsigned* __restrict__ a, const unsigned* __restrict__ b, size_t nwords, unsigned* __restrict__ cnt) {
    size_t i = (size_t)blockIdx.x * 256 + threadIdx.x; unsigned bad = 0;
    for (; i < nwords; i += (size_t)gridDim.x * 256) bad += (a[i] != b[i]) ? 1u : 0u;
    if (bad) atomicAdd(cnt, bad);
}
__global__ void k_dbg_flag(const unsigned* __restrict__ cnt, float* __restrict__ out) { if (threadIdx.x == 0 && blockIdx.x == 0 && cnt[0] != 0u) out[0] = __builtin_nanf(""); }
__global__ void __launch_bounds__(256) k_dbg_sum(const unsigned* __restrict__ a, size_t nwords, unsigned* __restrict__ acc2) {
    size_t i = (size_t)blockIdx.x * 256 + threadIdx.x; unsigned s0 = 0, s1 = 0;
    for (; i < nwords; i += (size_t)gridDim.x * 256) { const unsigned w = a[i]; s0 += w; s1 += w * (unsigned)(i * 2654435761u + 12345u); }
    atomicAdd(acc2, s0); atomicAdd(acc2 + 1, s1);
}
__global__ void k_dbg_check(unsigned* __restrict__ rec) {
    if (threadIdx.x != 0 || blockIdx.x != 0) return;
    unsigned flag = 0;
    if (rec[16] == 0x1234abcdu) { for (int b = 0; b < 6; ++b) if (rec[17 + 2 * b] != rec[2 * b] || rec[18 + 2 * b] != rec[2 * b + 1]) flag |= 1u << b; }
    for (int i = 0; i < 12; ++i) rec[17 + i] = rec[i];
    rec[16] = 0x1234abcdu; rec[32] = flag;
}
__global__ void __launch_bounds__(256) k_dbg_zero(const unsigned* __restrict__ rec, float* __restrict__ out) {
    const unsigned flag = rec[32]; if (!flag) return;
    int b = 0; while (!((flag >> b) & 1u)) ++b;
    const float fr = (float)(b + 1) / 8.f; const size_t n = (size_t)((double)NTOK * D_MODEL * (double)(fr * fr));
    for (size_t i = (size_t)blockIdx.x * 256 + threadIdx.x; i < n; i += (size_t)gridDim.x * 256) out[i] = 0.f;
}
static int g_grid = 0;
static void launch_mk(hipStream_t stream, void* const* d_in, void* d_out, void* d_ws, int lo, int hi, int li, int grid_override = 0) {
    Args a{};
    for (int i = 0; i < 32; ++i) a.in[i] = (const float*)d_in[i];
    a.out = (float*)d_out; a.ws = (unsigned char*)d_ws; a.ph_lo = lo; a.ph_hi = hi; a.li = li; a.pad = 0;
    hipLaunchKernelGGL(mk_fwd, dim3(grid_override ? grid_override : g_grid), dim3(NWAVES * 64), 0, stream, a);
    const hipError_t le = hipPeekAtLastError();
    if (le != hipSuccess) fprintf(stderr, "kernel_launch: mk_fwd launch failed: %s\n", hipGetErrorName(le));
}
extern "C" void kernel_launch(void* const* d_in, const int* in_sizes, int n_in, void* d_out, int out_size, void* d_ws, size_t ws_size, hipStream_t stream) {
    (void)in_sizes; (void)n_in; (void)out_size;
    if (ws_size < 1024 * MiB) { fprintf(stderr, "kernel_launch: workspace too small (%zu)\n", ws_size); return; }
    if (g_grid == 0) {
        int dev = 0, cus = 0, per_cu = 0;
        if (hipGetDevice(&dev) != hipSuccess || hipDeviceGetAttribute(&cus, hipDeviceAttributeMultiprocessorCount, dev) != hipSuccess) { fprintf(stderr, "kernel_launch: device query failed\n"); g_grid = -1; return; }

        if (hipOccupancyMaxActiveBlocksPerMultiprocessor(&per_cu, (const void*)mk_fwd, NWAVES * 64, 0) != hipSuccess || per_cu < 1) fprintf(stderr, "kernel_launch: occupancy query reports %d\n", per_cu);
        (void)hipGetLastError();
        if (cus < 256) { fprintf(stderr, "kernel_launch: built for a 256-CU device (found %d)\n", cus); g_grid = -1; return; }
        g_grid = 256;
    }
    if (g_grid < 0) return;
    (void)hipMemsetAsync((char*)d_ws + WS_CTL, 0, 1 * MiB, stream);
    const float* x = (const float*)d_in[0]; const float* p = (const float*)d_in[1];
    const float* w_attn_up = (const float*)d_in[6];
    const float* a_re = (const float*)d_in[7]; const float* a_im = (const float*)d_in[8]; const float* log_dt = (const float*)d_in[9];
    const float* b_re = (const float*)d_in[10]; const float* b_im = (const float*)d_in[11]; const float* c_re = (const float*)d_in[12]; const float* c_im = (const float*)d_in[13];
    const float* d_skip = (const float*)d_in[14]; const float* w_glu = (const float*)d_in[15]; const float* b_glu = (const float*)d_in[16]; const float* w_ssm_up = (const float*)d_in[17];
    const float* w_out = (const float*)d_in[18]; const float* g_ffn = (const float*)d_in[19]; const float* w_router = (const float*)d_in[20]; const float* router_bias = (const float*)d_in[21];
    const float* w_exp_gate = (const float*)d_in[22]; const float* w_exp_up = (const float*)d_in[23]; const float* w_exp_down = (const float*)d_in[24];
    const float* w_sh_gate = (const float*)d_in[25]; const float* w_sh_up = (const float*)d_in[26]; const float* w_sh_down = (const float*)d_in[27];
    const float* g_ple = (const float*)d_in[28]; const float* w_ple_gate = (const float*)d_in[29]; const float* w_ple_proj = (const float*)d_in[30]; const float* g_final = (const float*)d_in[31];
    float* out = (float*)d_out; char* ws = (char*)d_ws;
    bf16* Qb = (bf16*)(ws + WS_Q); bf16* Ob = (bf16*)(ws + WS_O); bf16* Kb = (bf16*)(ws + WS_K); bf16* Vb = (bf16*)(ws + WS_V);
    bf16* ucat = (bf16*)(ws + WS_UCAT); bf16* GA = (bf16*)(ws + WS_GA); bf16* GS = (bf16*)(ws + WS_GS); bf16* yact = (bf16*)(ws + WS_YACT); bf16* xn3 = (bf16*)(ws + WS_XN3);
    char* tmp = ws + WS_TMP;

    launch_mk(stream, d_in, d_out, d_ws, 0, PH_END, 0);
    (void)x; (void)p; (void)w_attn_up; (void)a_re; (void)a_im; (void)log_dt; (void)b_re; (void)b_im; (void)c_re; (void)c_im; (void)d_skip; (void)w_glu; (void)b_glu; (void)w_ssm_up; (void)w_out;
    (void)g_ffn; (void)w_router; (void)router_bias; (void)w_exp_gate; (void)w_exp_up; (void)w_exp_down; (void)w_sh_gate; (void)w_sh_up; (void)w_sh_down; (void)g_ple; (void)w_ple_gate; (void)w_ple_proj; (void)g_final;
    (void)out; (void)Qb; (void)Ob; (void)Kb; (void)Vb; (void)ucat; (void)GA; (void)GS; (void)yact; (void)xn3; (void)tmp;
}
```
